# Optimizing an MI355X kernel written in HIP

```python
import math
import jax, jax.numpy as jnp
from jax import lax
import numpy as np

D_MODEL = 2048
BATCH = 16
SEQ = 2048
DEPTH = 1
DEC_BATCH = 4
DEC_SEQ = 4096
PAST_LEN = 128

DILATED_GROUPS = ((128, 1), (512, 4), (2048, 16))
N_DIL_GROUPS = 3
GROUP_HEADS = 4
ATTN_HEAD_DIM = 128
ATTN_HEADS = N_DIL_GROUPS * GROUP_HEADS
ATTN_WIDTH = ATTN_HEADS * ATTN_HEAD_DIM
ATTN_OUT = GROUP_HEADS * ATTN_HEAD_DIM
FNET_GROUPS = 4
FNET_GROUP_DIM = 256
FNET_WIDTH = FNET_GROUPS * FNET_GROUP_DIM
MEM_TOKENS = 256
MEM_HEADS = 4
MEM_HEAD_DIM = 256
MEM_WIDTH = MEM_HEADS * MEM_HEAD_DIM
IN_WIDTH = 3 * ATTN_WIDTH + FNET_WIDTH + MEM_WIDTH
N_BRANCHES = 3
D_FF = 5632
N_BUCKETS = 32
MAX_EXACT = 8
REL_MAX_DIST = 1024
RMS_EPS = 1e-6
NEG_INF = -1e30

kernel_name = "hybrid_dilated_fnet_memory_encoder"


def _rms(x, g):
    xf = x.astype(jnp.float32)
    y = xf * lax.rsqrt(jnp.mean(xf * xf, axis=-1, keepdims=True) + RMS_EPS)
    return (y * g.astype(jnp.float32)).astype(x.dtype)


def _swiglu(h, w_in, w_out):
    a, b = jnp.split(h @ w_in, 2, axis=-1)
    return (jax.nn.silu(a) * b) @ w_out


def _t5_bucket(rel):
    half = N_BUCKETS // 2
    n = jnp.abs(rel)
    nf = jnp.maximum(n, 1).astype(jnp.float32)
    large = MAX_EXACT + (jnp.log(nf / MAX_EXACT) / math.log(REL_MAX_DIST / MAX_EXACT)
                         * (half - MAX_EXACT)).astype(jnp.int32)
    large = jnp.minimum(large, half - 1)
    return jnp.where(rel > 0, half, 0) + jnp.where(n < MAX_EXACT, n, large)


def _dilated_group(q, k, v, window, dil, bias_table):
    B, S, H, E = q.shape
    L = S // dil
    R = window // (2 * dil)
    nblk = -(-L // R)
    Lp = nblk * R

    def sub(t):
        return t.reshape(B, L, dil, H, E).transpose(0, 2, 1, 3, 4)

    qs = jnp.pad(sub(q), ((0, 0), (0, 0), (0, Lp - L), (0, 0), (0, 0))).reshape(B, dil, nblk, R, H, E)

    def key_blocks(t):
        tp = jnp.pad(sub(t), ((0, 0), (0, 0), (R, Lp - L + R), (0, 0), (0, 0)))
        tp = tp.reshape(B, dil, nblk + 2, R, H, E)
        return jnp.concatenate([tp[:, :, :-2], tp[:, :, 1:-1], tp[:, :, 2:]], axis=3)

    kb = key_blocks(k)
    vb = key_blocks(v)
    s_idx = jnp.arange(R)[:, None]
    t_idx = jnp.arange(3 * R)[None, :]
    delta = t_idx - R - s_idx
    bias = bias_table[_t5_bucket(delta * dil)].transpose(2, 0, 1).astype(jnp.float32)
    key_sub = jnp.arange(nblk)[:, None, None] * R - R + t_idx[None]
    valid = (jnp.abs(delta) <= R)[None] & (key_sub >= 0) & (key_sub < L)

    logits = jnp.einsum('bdnqhe,bdnkhe->bdnhqk', qs, kb).astype(jnp.float32) * (E ** -0.5) + bias
    logits = jnp.where(valid[:, None], logits, NEG_INF)
    m = jnp.max(logits, axis=-1, keepdims=True)
    p = jnp.exp(logits - m)
    den = jnp.sum(p, axis=-1, keepdims=True)
    o = jnp.einsum('bdnhqk,bdnkhe->bdnqhe', p / den, vb.astype(jnp.float32))
    lse = (m + jnp.log(den))[..., 0]
    o = o.reshape(B, dil, Lp, H, E)[:, :, :L].transpose(0, 2, 1, 3, 4).reshape(B, S, H, E)
    lse = lse.transpose(0, 1, 2, 4, 3).reshape(B, dil, Lp, H)[:, :, :L].transpose(0, 2, 1, 3).reshape(B, S, H)
    return o, lse


def _dilated_mixture(q, k, v, rel_bias):
    B, S = q.shape[:2]
    outs, lses = [], []
    for g, (window, dil) in enumerate(DILATED_GROUPS):
        o, lse = _dilated_group(q[:, :, g], k[:, :, g], v[:, :, g], window, dil,
                                rel_bias[:, g * GROUP_HEADS:(g + 1) * GROUP_HEADS])
        outs.append(o)
        lses.append(lse)
    alpha = jax.nn.softmax(jnp.stack(lses, axis=0), axis=0)
    o = jnp.sum(alpha[..., None] * jnp.stack(outs, axis=0), axis=0)
    return o.reshape(B, S, ATTN_OUT).astype(q.dtype)


def _fourier(u):
    B, S, _ = u.shape
    ug = u.reshape(B, S, FNET_GROUPS, FNET_GROUP_DIM).astype(jnp.float32)
    f = jnp.fft.fft2(ug, axes=(1, 3), norm="ortho").real
    return f.reshape(B, S, FNET_WIDTH).astype(u.dtype)


def _memory(q_m, mem, mem_norm, w_mem_kv):
    B, S, _ = q_m.shape
    M = mem.shape[1]
    kv = (_rms(mem, mem_norm) @ w_mem_kv).reshape(B, M, 2, MEM_HEADS, MEM_HEAD_DIM)
    q = q_m.reshape(B, S, MEM_HEADS, MEM_HEAD_DIM)
    logits = jnp.einsum('bshe,bmhe->bhsm', q, kv[:, :, 0]).astype(jnp.float32) * (MEM_HEAD_DIM ** -0.5)
    p = jax.nn.softmax(logits, axis=-1)
    o = jnp.einsum('bhsm,bmhe->bshe', p, kv[:, :, 1].astype(jnp.float32))
    return o.reshape(B, S, MEM_WIDTH).astype(q_m.dtype)


def _layer(x, mem, rel_bias, f1_pre, f1_wi, f1_wo, f1_post, mix_pre, mem_norm, w_in, w_mem_kv,
           w_gate, b_gate, w_pa, w_pf, w_pm, w_out, mix_post, f2_pre, f2_wi, f2_wo, f2_post):
    B, S, D = x.shape
    x = x + 0.5 * _rms(_swiglu(_rms(x, f1_pre), f1_wi, f1_wo), f1_post)
    h = _rms(x, mix_pre)
    z = h @ w_in
    qkv_a = z[..., :3 * ATTN_WIDTH].reshape(B, S, 3, N_DIL_GROUPS, GROUP_HEADS, ATTN_HEAD_DIM)
    u_f = z[..., 3 * ATTN_WIDTH:3 * ATTN_WIDTH + FNET_WIDTH]
    q_m = z[..., 3 * ATTN_WIDTH + FNET_WIDTH:]
    a = _dilated_mixture(qkv_a[:, :, 0], qkv_a[:, :, 1], qkv_a[:, :, 2], rel_bias)
    f = _fourier(u_f)
    m = _memory(q_m, mem, mem_norm, w_mem_kv)
    gates = jax.nn.sigmoid((h @ w_gate + b_gate).astype(jnp.float32)).astype(x.dtype).reshape(B, S, N_BRANCHES, D)
    merged = gates[:, :, 0] * (a @ w_pa) + gates[:, :, 1] * (f @ w_pf) + gates[:, :, 2] * (m @ w_pm)
    x = x + _rms(merged @ w_out, mix_post)
    x = x + 0.5 * _rms(_swiglu(_rms(x, f2_pre), f2_wi, f2_wo), f2_post)
    return x


def setup_inputs(seed: int = 0) -> dict:
    key = jax.random.key(seed)
    ks = jax.random.split(key, 32)
    f32 = jnp.float32

    def w(k, shape, fan_in):
        return jax.random.normal(k, shape, f32) * (fan_in ** -0.5)

    def gain(k):
        return 1.0 + 0.01 * jax.random.normal(k, (DEPTH, D_MODEL), f32)

    return {
        "x_prompt": jax.random.normal(ks[0], (BATCH, SEQ, D_MODEL), f32),
        "x_sample": jax.random.normal(ks[1], (DEC_BATCH, DEC_SEQ, D_MODEL), f32),
        "mem_prompt": jax.random.normal(ks[2], (BATCH, MEM_TOKENS, D_MODEL), f32),
        "mem_sample": jax.random.normal(ks[3], (DEC_BATCH, MEM_TOKENS, D_MODEL), f32),
        "rel_bias": 0.1 * jax.random.normal(ks[4], (N_BUCKETS, ATTN_HEADS), f32),
        "ffn1_norm_pre": gain(ks[5]),
        "ffn1_w_in": w(ks[6], (DEPTH, D_MODEL, 2 * D_FF), D_MODEL),
        "ffn1_w_out": w(ks[7], (DEPTH, D_FF, D_MODEL), D_FF),
        "ffn1_norm_post": gain(ks[8]),
        "mix_norm_pre": gain(ks[9]),
        "mem_norm": gain(ks[10]),
        "w_in": w(ks[11], (DEPTH, D_MODEL, IN_WIDTH), D_MODEL),
        "w_mem_kv": w(ks[12], (DEPTH, D_MODEL, 2 * MEM_WIDTH), D_MODEL),
        "w_gate": w(ks[13], (DEPTH, D_MODEL, N_BRANCHES * D_MODEL), D_MODEL),
        "b_gate": 0.01 * jax.random.normal(ks[14], (DEPTH, N_BRANCHES * D_MODEL), f32),
        "w_proj_attn": w(ks[15], (DEPTH, ATTN_OUT, D_MODEL), ATTN_OUT),
        "w_proj_fnet": w(ks[16], (DEPTH, FNET_WIDTH, D_MODEL), FNET_WIDTH),
        "w_proj_mem": w(ks[17], (DEPTH, MEM_WIDTH, D_MODEL), MEM_WIDTH),
        "w_out": w(ks[18], (DEPTH, D_MODEL, D_MODEL), D_MODEL),
        "mix_norm_post": gain(ks[19]),
        "ffn2_norm_pre": gain(ks[20]),
        "ffn2_w_in": w(ks[21], (DEPTH, D_MODEL, 2 * D_FF), D_MODEL),
        "ffn2_w_out": w(ks[22], (DEPTH, D_FF, D_MODEL), D_FF),
        "ffn2_norm_post": gain(ks[23]),
    }


def reference(x_prompt, x_sample, mem_prompt, mem_sample, rel_bias,
              ffn1_norm_pre, ffn1_w_in, ffn1_w_out, ffn1_norm_post,
              mix_norm_pre, mem_norm, w_in, w_mem_kv, w_gate, b_gate,
              w_proj_attn, w_proj_fnet, w_proj_mem, w_out, mix_norm_post,
              ffn2_norm_pre, ffn2_w_in, ffn2_w_out, ffn2_norm_post):
    y_prompt = x_prompt
    y_sample = x_sample
    for l in range(DEPTH):
        lw = (ffn1_norm_pre[l], ffn1_w_in[l], ffn1_w_out[l], ffn1_norm_post[l],
              mix_norm_pre[l], mem_norm[l], w_in[l], w_mem_kv[l], w_gate[l], b_gate[l],
              w_proj_attn[l], w_proj_fnet[l], w_proj_mem[l], w_out[l], mix_norm_post[l],
              ffn2_norm_pre[l], ffn2_w_in[l], ffn2_w_out[l], ffn2_norm_post[l])
        y_prompt = _layer(y_prompt, mem_prompt, rel_bias, *lw)
        y_sample = _layer(y_sample, mem_sample, rel_bias, *lw)
    return (y_prompt, y_sample)
```

```cpp
#include <hip/hip_runtime.h>
#include <hip/hip_cooperative_groups.h>
#include <cstdio>
#include <cstdint>
namespace cg = cooperative_groups;

#ifndef MK_COOP
#define MK_COOP 1
#endif

#define LAS __attribute__((address_space(3)))
typedef unsigned short bf16_t;
typedef short bf16x8 __attribute__((ext_vector_type(8)));
typedef float f32x4 __attribute__((ext_vector_type(4)));
typedef float f32x16 __attribute__((ext_vector_type(16)));
typedef unsigned u32x4 __attribute__((ext_vector_type(4)));
typedef unsigned u32x2 __attribute__((ext_vector_type(2)));

constexpr int TT = 49152, DM = 2048, DFF = 5632, NIN = 6656, NGT = 6144, CH = 16384, NAFM = 2560;
constexpr int TP = 32768;
constexpr float RMS_EPS = 1e-6f;
constexpr float LOG2E = 1.4426950408889634f;
constexpr size_t MiB = 1u << 20;
constexpr size_t WS_W1U = 1 * MiB;
constexpr size_t WS_W1D = WS_W1U + 44 * MiB;
constexpr size_t WS_W2U = WS_W1D + 22 * MiB;
constexpr size_t WS_W2D = WS_W2U + 44 * MiB;
constexpr size_t WS_WIN = WS_W2D + 22 * MiB;
constexpr size_t WS_WG = WS_WIN + 26 * MiB;
constexpr size_t WS_WKV = WS_WG + 24 * MiB;
constexpr size_t WS_WP = WS_WKV + 8 * MiB;
constexpr size_t WS_WO = WS_WP + 10 * MiB;
constexpr size_t WS_XN = WS_WO + 8 * MiB;
constexpr size_t WS_H = WS_XN + 192 * MiB;
constexpr size_t WS_ZG = WS_H;
constexpr size_t WS_AFM = WS_ZG + 208 * MiB;
constexpr size_t WS_YT = WS_AFM + 80 * MiB;
constexpr size_t WS_LSE = WS_YT + 64 * MiB;
constexpr size_t WS_DS2 = WS_LSE + 1 * MiB;
constexpr size_t WS_DS4 = WS_DS2 + 16 * MiB;
constexpr size_t WS_D256 = WS_DS4 + 64 * MiB;
constexpr size_t WS_MEMN = WS_D256 + 1 * MiB;
constexpr size_t WS_KV = WS_MEMN + 20 * MiB;
constexpr size_t WS_END = WS_H + 528 * MiB;
static_assert(WS_KV + 20 * MiB <= WS_END, "overlay map");

constexpr int LDS_BYTES = 139264;

__device__ __forceinline__ unsigned cvt_pk_bf16(float lo, float hi) { unsigned r; asm volatile("v_cvt_pk_bf16_f32 %0, %1, %2" : "=v"(r) : "v"(lo), "v"(hi)); return r; }
__device__ __forceinline__ float bf_lo(unsigned u) { return __uint_as_float(u << 16); }
__device__ __forceinline__ float bf_hi(unsigned u) { return __uint_as_float(u & 0xffff0000u); }
__device__ __forceinline__ float wave_sum(float v) {
#pragma unroll
    for (int o = 1; o < 64; o <<= 1) v += __shfl_xor(v, o);
    return v;
}
__device__ __forceinline__ float sigmoidf_(float x) { return __builtin_amdgcn_rcpf(1.0f + __builtin_amdgcn_exp2f(-x * LOG2E)); }

namespace pg8 {
constexpr int BM = 256, BK = 64, HALF = 128, HTB = HALF * BK * 2, STAGE_BYTES = 8 * HTB, NXCD = 8, WGM = 8;
__host__ __device__ __forceinline__ int lds_byte(int r, int c) { const int st = (r >> 4) * 2 + (c >> 5), rr = r & 15, cc = c & 31, ob = rr * 64 + cc * 2; return st * 1024 + (ob ^ (((ob >> 9) & 1) << 5)); }
__host__ __device__ __forceinline__ void stage_rc(int b, int& R, int& C) { const int st = b / 1024, sb = b % 1024, swz = sb ^ (((sb >> 9) & 1) << 5); R = (st >> 1) * 16 + swz / 64; C = (st & 1) * 32 + (swz % 64) / 2; }
__host__ __device__ __forceinline__ int perm32(int rho) { const int n = rho >> 4, i = rho & 15; return 8 * (i >> 2) + 4 * n + (i & 3); }

struct Unit { const char* A; const char* B; bf16_t* C; const bf16_t* C2; int nt; int aux; };
struct PN { int pm, pn; };
struct StaticOrder {
    int nM, nN, nwg, G, c;
    __device__ void init(int M, int N, int G_, int c_) { nM = M / BM; nN = N / BM; nwg = nM * nN; G = G_; c = c_; }
    __device__ bool next(int i, PN& u) const {
        const long L = (long)i * G + c; if (L >= nwg) return false;
        int wgid = (int)L; { const int q = nwg / NXCD, r = nwg % NXCD, xcd = wgid % NXCD, off = wgid / NXCD; wgid = (xcd < r ? xcd * (q + 1) : r * (q + 1) + (xcd - r) * q) + off; }
        const int nig = WGM * nN, gid = wgid / nig, fm = gid * WGM, gsz = (nM - fm) < WGM ? (nM - fm) : WGM;
        u.pm = fm + ((wgid % nig) % gsz); u.pn = (wgid % nig) / gsz; return true;
    }
};

template <int ACT> struct EpiStore {
    int ldc; const float* bias;
    __device__ __forceinline__ void operator()(const f32x4 (&acc)[2][2][4][2], const Unit& u, int wr, int wc, int fr, int fq) const {
        bf16_t* base = u.C + (size_t)(wr * 64 + fr) * ldc + wc * 32 + 8 * fq;
        f32x4 bv[2][2];
        if (ACT == 1) {
#pragma unroll
            for (int bj = 0; bj < 2; ++bj)
#pragma unroll
                for (int n = 0; n < 2; ++n) bv[bj][n] = *(const f32x4*)(bias + u.aux + bj * HALF + wc * 32 + 8 * fq + 4 * n);
        }
#pragma unroll
        for (int ai = 0; ai < 2; ++ai)
#pragma unroll
            for (int m = 0; m < 4; ++m) { bf16_t* rowp = base + (size_t)(ai * HALF + m * 16) * ldc;
#pragma unroll
                for (int bj = 0; bj < 2; ++bj) { f32x4 v0 = acc[ai][bj][m][0], v1 = acc[ai][bj][m][1];
                    if (ACT == 1) { v0 = v0 + bv[bj][0]; v1 = v1 + bv[bj][1];
#pragma unroll
                        for (int e = 0; e < 4; ++e) { v0[e] = sigmoidf_(v0[e]); v1[e] = sigmoidf_(v1[e]); } }
                    u32x4 w; w.x = cvt_pk_bf16(v0[0], v0[1]); w.y = cvt_pk_bf16(v0[2], v0[3]); w.z = cvt_pk_bf16(v1[0], v1[1]); w.w = cvt_pk_bf16(v1[2], v1[3]);
                    *(u32x4*)(rowp + bj * HALF) = w; } }
    }
};
struct EpiSwiGLU {
    int ldc;
    __device__ __forceinline__ void operator()(const f32x4 (&acc)[2][2][4][2], const Unit& u, int wr, int wc, int fr, int fq) const {
        bf16_t* base = u.C + (size_t)(wr * 64 + fr) * ldc + wc * 32 + 8 * fq;
#pragma unroll
        for (int ai = 0; ai < 2; ++ai)
#pragma unroll
            for (int m = 0; m < 4; ++m) { bf16_t* rowp = base + (size_t)(ai * HALF + m * 16) * ldc;
                f32x4 v0, v1;
#pragma unroll
                for (int e = 0; e < 4; ++e) { const float a0 = acc[ai][0][m][0][e], a1 = acc[ai][0][m][1][e];
                    v0[e] = a0 * sigmoidf_(a0) * acc[ai][1][m][0][e]; v1[e] = a1 * sigmoidf_(a1) * acc[ai][1][m][1][e]; }
                u32x4 w; w.x = cvt_pk_bf16(v0[0], v0[1]); w.y = cvt_pk_bf16(v0[2], v0[3]); w.z = cvt_pk_bf16(v1[0], v1[1]); w.w = cvt_pk_bf16(v1[2], v1[3]);
                *(u32x4*)rowp = w; }
    }
};
struct EpiGateRMW {
    int ldc; const float* bias;
    __device__ __forceinline__ void operator()(const f32x4 (&acc)[2][2][4][2], const Unit& u, int wr, int wc, int fr, int fq) const {
        const size_t off0 = (size_t)(wr * 64 + fr) * ldc + wc * 32 + 8 * fq;
        f32x4 bv[2][2];
#pragma unroll
        for (int bj = 0; bj < 2; ++bj)
#pragma unroll
            for (int n = 0; n < 2; ++n) bv[bj][n] = *(const f32x4*)(bias + (u.aux >> 2) + bj * HALF + wc * 32 + 8 * fq + 4 * n);
#pragma unroll
        for (int ai = 0; ai < 2; ++ai)
#pragma unroll
            for (int m = 0; m < 4; ++m) { const size_t ro = off0 + (size_t)(ai * HALF + m * 16) * ldc;
#pragma unroll
                for (int bj = 0; bj < 2; ++bj) {
                    const u32x4 g = *(const u32x4*)(u.C2 + ro + bj * HALF);
                    u32x4 o = (u32x4){0u, 0u, 0u, 0u}; if (u.aux & 3) o = *(const u32x4*)(u.C + ro + bj * HALF);
                    const f32x4 a0 = acc[ai][bj][m][0], a1 = acc[ai][bj][m][1];
                    const f32x4 b0 = bv[bj][0], b1 = bv[bj][1];
                    u32x4 w;
                    w.x = cvt_pk_bf16(bf_lo(o.x) + sigmoidf_(bf_lo(g.x) + b0[0]) * a0[0], bf_hi(o.x) + sigmoidf_(bf_hi(g.x) + b0[1]) * a0[1]);
                    w.y = cvt_pk_bf16(bf_lo(o.y) + sigmoidf_(bf_lo(g.y) + b0[2]) * a0[2], bf_hi(o.y) + sigmoidf_(bf_hi(g.y) + b0[3]) * a0[3]);
                    w.z = cvt_pk_bf16(bf_lo(o.z) + sigmoidf_(bf_lo(g.z) + b1[0]) * a1[0], bf_hi(o.z) + sigmoidf_(bf_hi(g.z) + b1[1]) * a1[1]);
                    w.w = cvt_pk_bf16(bf_lo(o.w) + sigmoidf_(bf_lo(g.w) + b1[2]) * a1[2], bf_hi(o.w) + sigmoidf_(bf_hi(g.w) + b1[3]) * a1[3]);
                    *(u32x4*)(u.C + ro + bj * HALF) = w; } }
    }
};

template <class Epi, class Sched>
__device__ __forceinline__ void gemm_phase(LAS unsigned char* lds, const int tid, const int lda, const int ldb, const Sched& S, const Epi& E) {
    const int wid = __builtin_amdgcn_readfirstlane(tid >> 6), lane = tid & 63, wr = wid >> 2, wc = wid & 3, fr = lane & 15, fq = lane >> 4;
    unsigned voffA[2], voffB[2];
#pragma unroll
    for (int i = 0; i < 2; ++i) { int R, C; stage_rc(tid * 16 + i * 8192, R, C); const int Rb = (R & ~31) + perm32(R & 31);
        voffA[i] = (unsigned)(R * lda + C) * 2u; voffB[i] = (unsigned)(Rb * ldb + C) * 2u; }
    const size_t kstep = (size_t)(BK * 2);
    const size_t hstepA = (size_t)HALF * lda * 2, hstepB = (size_t)HALF * ldb * 2;
    const unsigned ldsw = (unsigned)wid * 1024u;
    const int aoff = lds_byte(wr * 64 + fr, fq * 8), boff = lds_byte(wc * 32 + fr, fq * 8);
#define PG8_SA(b, h) (((b) * 2 + (h)) * HTB)
#define PG8_SB(b, h) ((4 + (b) * 2 + (h)) * HTB)
#define PG8_STAGE(bufoff, gbase, voff) do { _Pragma("unroll") for (int _i = 0; _i < 2; ++_i) \
        __builtin_amdgcn_global_load_lds((const unsigned*)((const char*)(gbase) + (voff)[_i]), (LAS unsigned*)(lds + (bufoff) + ldsw + _i * 8192), 16, 0, 0); } while (0)
#define PG8_LDA(dst, b, h) do { _Pragma("unroll") for (int m = 0; m < 4; ++m) _Pragma("unroll") for (int k = 0; k < 2; ++k) dst[m][k] = *(const LAS bf16x8*)(lds + PG8_SA(b, h) + aoff + m * 2048 + k * 1024); } while (0)
#define PG8_LDB(dst, b, h) do { _Pragma("unroll") for (int n = 0; n < 2; ++n) _Pragma("unroll") for (int k = 0; k < 2; ++k) dst[n][k] = *(const LAS bf16x8*)(lds + PG8_SB(b, h) + boff + n * 2048 + k * 1024); } while (0)
#define PG8_MMA(ai, bj, At, Bt) do { __builtin_amdgcn_s_setprio(1); _Pragma("unroll") for (int m = 0; m < 4; ++m) _Pragma("unroll") for (int n = 0; n < 2; ++n) _Pragma("unroll") for (int k = 0; k < 2; ++k) \
        acc[ai][bj][m][n] = __builtin_amdgcn_mfma_f32_16x16x32_bf16(Bt[n][k], At[m][k], acc[ai][bj][m][n], 0, 0, 0); __builtin_amdgcn_s_setprio(0); } while (0)
#define PG8_WAIT_V(n) asm volatile("s_waitcnt vmcnt(" #n ")" ::: "memory")
#define PG8_WAIT_L(n) asm volatile("s_waitcnt lgkmcnt(" #n ")" ::: "memory")
#define PG8_BAR __builtin_amdgcn_s_barrier()
#define PG8_SCHED __builtin_amdgcn_sched_barrier(0)
    Unit cur, nxt; int ui = 0;
    if (!S.next(0, cur)) return;
    f32x4 acc[2][2][4][2];
#pragma unroll
    for (int a = 0; a < 2; ++a)
#pragma unroll
        for (int b = 0; b < 2; ++b)
#pragma unroll
            for (int m = 0; m < 4; ++m)
#pragma unroll
                for (int n = 0; n < 2; ++n) acc[a][b][m][n] = (f32x4){0.f, 0.f, 0.f, 0.f};
    bf16x8 At[4][2], B0[2][2], B1[2][2];
    const char* cA = cur.A; const char* cB = cur.B;
    PG8_STAGE(PG8_SB(0, 0), cB, voffB); PG8_STAGE(PG8_SB(0, 1), cB + hstepB, voffB); PG8_STAGE(PG8_SA(0, 0), cA, voffA); PG8_STAGE(PG8_SA(0, 1), cA + hstepA, voffA);
    if (wr == 1) PG8_BAR;
    PG8_WAIT_V(2); PG8_BAR;
    PG8_STAGE(PG8_SB(1, 0), cB + kstep, voffB); PG8_STAGE(PG8_SA(1, 0), cA + kstep, voffA); PG8_STAGE(PG8_SB(1, 1), cB + hstepB + kstep, voffB);
    PG8_WAIT_V(6); PG8_BAR;
    for (;;) {
        const bool has_next = S.next(ui + 1, nxt);
        const char* nA = has_next ? nxt.A : cA; const char* nB = has_next ? nxt.B : cB;
        int nt = cur.nt; asm volatile("" : "+s"(nt));
        for (int t = 0; t < nt; t += 2) {
            const bool last = (t == nt - 2);
            const char* a1 = cA + (size_t)(t + 1) * kstep;
            const char* a2 = last ? nA : cA + (size_t)(t + 2) * kstep; const char* b2 = last ? nB : cB + (size_t)(t + 2) * kstep;
            const char* a3 = a2 + kstep; const char* b3 = b2 + kstep;
            PG8_LDB(B0, 0, 0); PG8_LDB(B1, 0, 1); PG8_SCHED; PG8_LDA(At, 0, 0); PG8_STAGE(PG8_SA(1, 1), a1 + hstepA, voffA);
            PG8_WAIT_V(8); PG8_WAIT_L(0); PG8_BAR; PG8_MMA(0, 0, At, B0); PG8_MMA(0, 1, At, B1); PG8_BAR; PG8_SCHED;
            PG8_LDA(At, 0, 1); PG8_STAGE(PG8_SB(0, 0), b2, voffB); PG8_STAGE(PG8_SB(0, 1), b2 + hstepB, voffB); PG8_STAGE(PG8_SA(0, 0), a2, voffA);
            PG8_WAIT_V(8); PG8_WAIT_L(0); PG8_BAR; PG8_MMA(1, 0, At, B0); PG8_MMA(1, 1, At, B1); PG8_BAR; PG8_SCHED;
            PG8_LDB(B0, 1, 0); PG8_LDB(B1, 1, 1); PG8_SCHED; PG8_LDA(At, 1, 0); PG8_STAGE(PG8_SA(0, 1), a2 + hstepA, voffA);
            PG8_WAIT_V(8); PG8_WAIT_L(0); PG8_BAR; PG8_MMA(0, 0, At, B0); PG8_MMA(0, 1, At, B1); PG8_BAR; PG8_SCHED;
            PG8_LDA(At, 1, 1); PG8_STAGE(PG8_SB(1, 0), b3, voffB); PG8_STAGE(PG8_SB(1, 1), b3 + hstepB, voffB); PG8_STAGE(PG8_SA(1, 0), a3, voffA);
            PG8_WAIT_V(8); PG8_WAIT_L(0); PG8_BAR; PG8_MMA(1, 0, At, B0); PG8_MMA(1, 1, At, B1); PG8_BAR; PG8_SCHED;
        }
        if (wr == 0) PG8_BAR;
        E(acc, cur, wr, wc, fr, fq);
        if (!has_next) break;
#pragma unroll
        for (int a = 0; a < 2; ++a)
#pragma unroll
            for (int b = 0; b < 2; ++b)
#pragma unroll
                for (int m = 0; m < 4; ++m)
#pragma unroll
                    for (int n = 0; n < 2; ++n) acc[a][b][m][n] = (f32x4){0.f, 0.f, 0.f, 0.f};
        cur = nxt; cA = nA; cB = nB; ++ui;
        if (wr == 1) PG8_BAR;
    }
    PG8_WAIT_V(0);
    PG8_BAR;
#undef PG8_SA
#undef PG8_SB
#undef PG8_STAGE
#undef PG8_LDA
#undef PG8_LDB
#undef PG8_MMA
#undef PG8_WAIT_V
#undef PG8_WAIT_L
#undef PG8_BAR
#undef PG8_SCHED
}
}

struct SchedStd {
    pg8::StaticOrder so; const char* A; const char* B; bf16_t* C; size_t a_tile, b_tile; int ldc, ccols, nt;
    __device__ __forceinline__ bool next(int i, pg8::Unit& u) const {
        pg8::PN p; if (!so.next(i, p)) return false;
        u.A = A + (size_t)p.pm * a_tile; u.B = B + (size_t)p.pn * b_tile; u.C = C + (size_t)p.pm * 256 * ldc + (size_t)p.pn * ccols; u.C2 = nullptr; u.nt = nt; u.aux = p.pn * 256; return true; }
};
struct SchedF1 {
    const char* D; const char* Z; bf16_t* Yt; int S, nunits, G, c;
    __device__ __forceinline__ bool next(int i, pg8::Unit& u) const {
        const int L = i * G + c; if (L >= nunits) return false;
        const int lg = (S == 4096) ? 4 : 3; const int pn = L & ((1 << lg) - 1); int t = L >> lg; const int pm = t & 1; t >>= 1; const int g = t & 3; const int b = t >> 2;
        u.A = D + (size_t)pm * 256 * 256 * 2; u.B = Z + ((size_t)(b * S + pn * 256) * NIN + 4608 + g * 256) * 2;
        u.C = Yt + (size_t)(b * 1024 + g * 256) * (2 * S) + (size_t)pm * S + pn * 256; u.C2 = nullptr; u.nt = 4; u.aux = 0; return true; }
};
struct SchedF2 {
    const char* DS; const char* Yt; bf16_t* AFM; int S, nunits, G, c;
    __device__ __forceinline__ bool next(int i, pg8::Unit& u) const {
        const int L = i * G + c; if (L >= nunits) return false;
        const int lg = (S == 4096) ? 4 : 3; const int pn = L & 3; const int t = L >> 2; const int pm = t & ((1 << lg) - 1); const int b = t >> lg;
        u.A = DS + (size_t)pm * 256 * (2 * S) * 2; u.B = Yt + (size_t)(b * 1024 + pn * 256) * (2 * S) * 2;
        u.C = AFM + (size_t)(b * S + pm * 256) * NAFM + 512 + pn * 256; u.C2 = nullptr; u.nt = (2 * S) >> 6; u.aux = 0; return true; }
};
struct SchedP {
    pg8::StaticOrder so; const char* AFM; const char* WP; bf16_t* Gc;
    __device__ __forceinline__ bool next(int i, pg8::Unit& u) const {
        const int j = i / 3, b = i - 3 * j; pg8::PN p; if (!so.next(j, p)) return false;
        const int koff = (b == 0) ? 0 : (b == 1 ? 512 : 1536);
        u.A = AFM + ((size_t)p.pm * 256 * NAFM + koff) * 2; u.B = WP + ((size_t)p.pn * 256 * NAFM + koff) * 2;
        u.C = Gc + (size_t)p.pm * 256 * NGT + p.pn * 256; u.C2 = u.C + b * 2048; u.nt = (b == 0) ? 8 : 16; u.aux = b + 4 * (b * 2048 + p.pn * 256); return true; }
};

__device__ __forceinline__ void row_op(const bf16_t* y, const float* xin, float* xout, bf16_t* xn, const float* g_post, const float* g_pre, float cres, int lane) {
    float v[32];
#pragma unroll
    for (int j = 0; j < 4; ++j) { const int e0 = j * 512 + lane * 8; const f32x4 a = *(const f32x4*)(xin + e0), b = *(const f32x4*)(xin + e0 + 4);
#pragma unroll
        for (int e = 0; e < 4; ++e) { v[j * 8 + e] = a[e]; v[j * 8 + 4 + e] = b[e]; } }
    if (y) {
        float yv[32]; float ss = 0.f;
#pragma unroll
        for (int j = 0; j < 4; ++j) { const u32x4 w = *(const u32x4*)(y + j * 512 + lane * 8);
            yv[j * 8 + 0] = bf_lo(w.x); yv[j * 8 + 1] = bf_hi(w.x); yv[j * 8 + 2] = bf_lo(w.y); yv[j * 8 + 3] = bf_hi(w.y);
            yv[j * 8 + 4] = bf_lo(w.z); yv[j * 8 + 5] = bf_hi(w.z); yv[j * 8 + 6] = bf_lo(w.w); yv[j * 8 + 7] = bf_hi(w.w); }
#pragma unroll
        for (int i = 0; i < 32; ++i) ss += yv[i] * yv[i];
        ss = wave_sum(ss);
        const float rs = cres * (1.0f / sqrtf(ss * (1.0f / DM) + RMS_EPS));
#pragma unroll
        for (int j = 0; j < 4; ++j) { const int e0 = j * 512 + lane * 8; const f32x4 a = *(const f32x4*)(g_post + e0), b = *(const f32x4*)(g_post + e0 + 4);
#pragma unroll
            for (int e = 0; e < 4; ++e) { v[j * 8 + e] += yv[j * 8 + e] * rs * a[e]; v[j * 8 + 4 + e] += yv[j * 8 + 4 + e] * rs * b[e]; } }
    }
    if (xout) {
#pragma unroll
        for (int j = 0; j < 4; ++j) { const int e0 = j * 512 + lane * 8;
            *(f32x4*)(xout + e0) = (f32x4){v[j * 8 + 0], v[j * 8 + 1], v[j * 8 + 2], v[j * 8 + 3]};
            *(f32x4*)(xout + e0 + 4) = (f32x4){v[j * 8 + 4], v[j * 8 + 5], v[j * 8 + 6], v[j * 8 + 7]}; }
    }
    if (xn) {
        float ss = 0.f;
#pragma unroll
        for (int i = 0; i < 32; ++i) ss += v[i] * v[i];
        ss = wave_sum(ss);
        const float rs = 1.0f / sqrtf(ss * (1.0f / DM) + RMS_EPS);
#pragma unroll
        for (int j = 0; j < 4; ++j) { const int e0 = j * 512 + lane * 8; const f32x4 a = *(const f32x4*)(g_pre + e0), b = *(const f32x4*)(g_pre + e0 + 4);
            u32x4 w; w.x = cvt_pk_bf16(v[j * 8 + 0] * rs * a[0], v[j * 8 + 1] * rs * a[1]); w.y = cvt_pk_bf16(v[j * 8 + 2] * rs * a[2], v[j * 8 + 3] * rs * a[3]);
            w.z = cvt_pk_bf16(v[j * 8 + 4] * rs * b[0], v[j * 8 + 5] * rs * b[1]); w.w = cvt_pk_bf16(v[j * 8 + 6] * rs * b[2], v[j * 8 + 7] * rs * b[3]);
            *(u32x4*)(xn + e0) = w; }
    }
}

__device__ __forceinline__ void transpose_item(const float* W, int N, bf16_t* WT, int ldk, int koff, int row_off, int k0, int n0, LAS float* scr, int lane) {
#pragma unroll 8
    for (int i = 0; i < 32; ++i) { const int kk = 2 * i + (lane >> 5); scr[kk * 33 + (lane & 31)] = W[(size_t)(k0 + kk) * N + n0 + (lane & 31)]; }
    asm volatile("s_waitcnt lgkmcnt(0)" ::: "memory");
    const int c = lane & 7;
#pragma unroll
    for (int j = 0; j < 4; ++j) { const int n = (lane >> 3) + 8 * j; const LAS float* s = scr + (8 * c) * 33 + n;
        u32x4 o; o.x = cvt_pk_bf16(s[0 * 33], s[1 * 33]); o.y = cvt_pk_bf16(s[2 * 33], s[3 * 33]); o.z = cvt_pk_bf16(s[4 * 33], s[5 * 33]); o.w = cvt_pk_bf16(s[6 * 33], s[7 * 33]);
        *(u32x4*)(WT + (size_t)(row_off + n) * ldk + koff + k0 + 8 * c) = o; }
    asm volatile("s_waitcnt lgkmcnt(0)" ::: "memory");
}
__device__ __forceinline__ void convert_weight(const float* W, int K, int N, bf16_t* WT, int ldk, int koff, bool swiglu_perm, LAS float* scr, int gw, int ngw, int lane) {
    const int nblk = N / 32, nitems = (K / 64) * nblk;
    for (int it = gw; it < nitems; it += ngw) {
        const int kb = it / nblk, nb = it - kb * nblk, n0 = nb * 32;
        int row_off = n0;
        if (swiglu_perm) { const int half = (n0 >= DFF) ? 1 : 0; const int n1 = n0 - half * DFF; row_off = (n1 >> 7) * 256 + half * 128 + (n1 & 127); }
        transpose_item(W, N, WT, ldk, koff, row_off - 0, kb * 64, n0, scr, lane);
    }
}

__device__ __forceinline__ int crow(int r, int hi) { return (r & 3) + 8 * (r >> 2) + 4 * hi; }
__device__ __forceinline__ bf16x8 pack8(const f32x16& s, int b) {
    u32x4 w; w.x = cvt_pk_bf16(s[b + 0], s[b + 1]); w.y = cvt_pk_bf16(s[b + 2], s[b + 3]); w.z = cvt_pk_bf16(s[b + 4], s[b + 5]); w.w = cvt_pk_bf16(s[b + 6], s[b + 7]);
    return __builtin_bit_cast(bf16x8, w);
}
__device__ __forceinline__ void dil_attn_unit(bf16_t* z, float* lse, const LAS float* biasL, int S, int unit, int lane) {
    const int h12 = unit >> 9, w = unit & 511;
    const int g = h12 >> 2, sh = 2 * g, L = S >> sh;
    const int spb = S >> 5; const int b = w / spb, v = w - b * spb; const int nlb = L >> 5; const int r = v / nlb, lb = v - r * nlb; const int l0 = lb * 32;
    const int q = lane & 31, hi = lane >> 5; const int lq = l0 + q;
    const size_t seqbase = (size_t)b * S;
    bf16_t* qrow = z + (seqbase + ((size_t)lq << sh) + r) * NIN + h12 * 128;
    bf16x8 qf[8];
#pragma unroll
    for (int ks = 0; ks < 8; ++ks) qf[ks] = *(const bf16x8*)(qrow + ks * 16 + hi * 8);
    f32x16 o[4];
#pragma unroll
    for (int dt = 0; dt < 4; ++dt)
#pragma unroll
        for (int i = 0; i < 16; ++i) o[dt][i] = 0.f;
    float m = -1e30f, lsum = 0.f;
    const float sc = 0.08838834764831845f * LOG2E;
    const LAS float* bl = biasL + h12 * 132 + 64;
    for (int kt = 0; kt < 5; ++kt) {
        const int kl0 = l0 - 64 + kt * 32;
        if (kl0 + 31 < 0 || kl0 >= L) continue;
        int kl = kl0 + q; kl = kl < 0 ? 0 : (kl > L - 1 ? L - 1 : kl);
        const bf16_t* kp = z + (seqbase + ((size_t)kl << sh) + r) * NIN + 1536 + h12 * 128 + hi * 8;
        f32x16 s;
#pragma unroll
        for (int i = 0; i < 16; ++i) s[i] = 0.f;
#pragma unroll
        for (int ks = 0; ks < 8; ++ks) { const bf16x8 kf = *(const bf16x8*)(kp + ks * 16); s = __builtin_amdgcn_mfma_f32_32x32x16_bf16(kf, qf[ks], s, 0, 0, 0); }
        float mx = -1e30f;
#pragma unroll
        for (int i = 0; i < 16; ++i) { const int lk = kl0 + crow(i, hi); const int dl = lk - lq; const bool valid = (dl >= -64) && (dl <= 64) && (lk >= 0) && (lk < L);
            const int di = dl < -64 ? -64 : (dl > 64 ? 64 : dl);
            const float vv = valid ? (s[i] * sc + bl[di]) : -1e30f; s[i] = vv; mx = fmaxf(mx, vv); }
        mx = fmaxf(mx, __shfl_xor(mx, 32));
        const float mn = fmaxf(m, mx); const float f = __builtin_amdgcn_exp2f(m - mn); m = mn;
        float ps = 0.f;
#pragma unroll
        for (int i = 0; i < 16; ++i) { const float p = __builtin_amdgcn_exp2f(s[i] - mn); s[i] = p; ps += p; }
        lsum = lsum * f + ps;
#pragma unroll
        for (int dt = 0; dt < 4; ++dt)
#pragma unroll
            for (int i = 0; i < 16; ++i) o[dt][i] *= f;
        const bf16x8 pa0 = pack8(s, 0), pa1 = pack8(s, 8);
#pragma unroll
        for (int s_ = 0; s_ < 2; ++s_) {
            const bf16_t* vr[8];
#pragma unroll
            for (int i = 0; i < 8; ++i) { int lk = kl0 + crow(8 * s_ + i, hi); lk = lk < 0 ? 0 : (lk > L - 1 ? L - 1 : lk);
                vr[i] = z + (seqbase + ((size_t)lk << sh) + r) * NIN + 3072 + h12 * 128 + q; }
#pragma unroll
            for (int dt = 0; dt < 4; ++dt) { bf16x8 vf;
#pragma unroll
                for (int i = 0; i < 8; ++i) vf[i] = (short)vr[i][dt * 32];
                o[dt] = __builtin_amdgcn_mfma_f32_32x32x16_bf16(vf, s_ ? pa1 : pa0, o[dt], 0, 0, 0); }
        }
    }
    lsum += __shfl_xor(lsum, 32);
    const float inv = 1.0f / lsum;
#pragma unroll
    for (int dt = 0; dt < 4; ++dt)
#pragma unroll
        for (int rg = 0; rg < 4; ++rg) { u32x2 w2; w2.x = cvt_pk_bf16(o[dt][4 * rg + 0] * inv, o[dt][4 * rg + 1] * inv); w2.y = cvt_pk_bf16(o[dt][4 * rg + 2] * inv, o[dt][4 * rg + 3] * inv);
            *(u32x2*)(qrow + dt * 32 + 8 * rg + 4 * hi) = w2; }
    if (hi == 0) lse[(seqbase + ((size_t)lq << sh) + r) * 12 + h12] = m + log2f(lsum);
}
__device__ __forceinline__ void mem_attn_unit(const bf16_t* z, const bf16_t* KVb, bf16_t* afm, int unit, int lane) {
    const int h = unit >> 9, w = unit & 511;
    const int q = lane & 31, hi = lane >> 5;
    const bf16_t* qp = z + (size_t)(w * 32 + q) * NIN + 5632 + h * 256 + hi * 8;
    f32x16 o[8];
#pragma unroll
    for (int dt = 0; dt < 8; ++dt)
#pragma unroll
        for (int i = 0; i < 16; ++i) o[dt][i] = 0.f;
    float m = -1e30f, lsum = 0.f;
    const float sc = 0.0625f * LOG2E;
    for (int kt = 0; kt < 8; ++kt) {
        const bf16_t* kp = KVb + (size_t)(kt * 32 + q) * 2048 + h * 256 + hi * 8;
        f32x16 s;
#pragma unroll
        for (int i = 0; i < 16; ++i) s[i] = 0.f;
#pragma unroll
        for (int ks = 0; ks < 16; ++ks) { const bf16x8 kf = *(const bf16x8*)(kp + ks * 16); const bf16x8 qf = *(const bf16x8*)(qp + ks * 16); s = __builtin_amdgcn_mfma_f32_32x32x16_bf16(kf, qf, s, 0, 0, 0); }
        float mx = -1e30f;
#pragma unroll
        for (int i = 0; i < 16; ++i) { s[i] *= sc; mx = fmaxf(mx, s[i]); }
        mx = fmaxf(mx, __shfl_xor(mx, 32));
        const float mn = fmaxf(m, mx); const float f = __builtin_amdgcn_exp2f(m - mn); m = mn;
        float ps = 0.f;
#pragma unroll
        for (int i = 0; i < 16; ++i) { const float p = __builtin_amdgcn_exp2f(s[i] - mn); s[i] = p; ps += p; }
        lsum = lsum * f + ps;
#pragma unroll
        for (int dt = 0; dt < 8; ++dt)
#pragma unroll
            for (int i = 0; i < 16; ++i) o[dt][i] *= f;
        const bf16x8 pa0 = pack8(s, 0), pa1 = pack8(s, 8);
#pragma unroll
        for (int s_ = 0; s_ < 2; ++s_) {
            const bf16_t* vb = KVb + (size_t)(kt * 32) * 2048 + 1024 + h * 256 + q;
#pragma unroll
            for (int dt = 0; dt < 8; ++dt) { bf16x8 vf;
#pragma unroll
                for (int i = 0; i < 8; ++i) vf[i] = (short)vb[(size_t)crow(8 * s_ + i, hi) * 2048 + dt * 32];
                o[dt] = __builtin_amdgcn_mfma_f32_32x32x16_bf16(vf, s_ ? pa1 : pa0, o[dt], 0, 0, 0); }
        }
    }
    lsum += __shfl_xor(lsum, 32);
    const float inv = 1.0f / lsum;
    bf16_t* op = afm + (size_t)(w * 32 + q) * NAFM + 1536 + h * 256;
#pragma unroll
    for (int dt = 0; dt < 8; ++dt)
#pragma unroll
        for (int rg = 0; rg < 4; ++rg) { u32x2 w2; w2.x = cvt_pk_bf16(o[dt][4 * rg + 0] * inv, o[dt][4 * rg + 1] * inv); w2.y = cvt_pk_bf16(o[dt][4 * rg + 2] * inv, o[dt][4 * rg + 3] * inv);
            *(u32x2*)(op + dt * 32 + 8 * rg + 4 * hi) = w2; }
}

__device__ __forceinline__ int t5_bucket(int rel) {
    const int n = rel < 0 ? -rel : rel; const float nf = (float)(n < 1 ? 1 : n);
    int large = 8 + (int)(logf(nf / 8.0f) / 4.852030263919617f * 8.0f); large = large < 15 ? large : 15;
    return (rel > 0 ? 16 : 0) + (n < 8 ? n : large);
}


struct Args { const float* in[24]; float* out; unsigned char* ws; int ph_lo, ph_hi, coop, pad; };
constexpr int N_PHASES = 28;

__global__ void __launch_bounds__(512, 2) mk_fwd(Args args) {
    extern __shared__ __attribute__((aligned(16))) unsigned char lds_raw[];
    LAS unsigned char* lds = (LAS unsigned char*)lds_raw;
    const int G = gridDim.x, bx = blockIdx.x;
    unsigned char* ws = args.ws;
    float* out = args.out;
    bf16_t* XN = (bf16_t*)(ws + WS_XN); bf16_t* Hb = (bf16_t*)(ws + WS_H);
    bf16_t* ZG = (bf16_t*)(ws + WS_ZG); bf16_t* AFM = (bf16_t*)(ws + WS_AFM); bf16_t* YT = (bf16_t*)(ws + WS_YT); float* LSE = (float*)(ws + WS_LSE);
    bf16_t* DS2 = (bf16_t*)(ws + WS_DS2); bf16_t* DS4 = (bf16_t*)(ws + WS_DS4); bf16_t* D256 = (bf16_t*)(ws + WS_D256);
    bf16_t* MEMN = (bf16_t*)(ws + WS_MEMN); bf16_t* KV = (bf16_t*)(ws + WS_KV);
#if MK_COOP
    cg::grid_group grid = cg::this_grid();
#endif

    for (int ph = args.ph_lo; ph < args.ph_hi; ++ph) {
        int tid = threadIdx.x; asm volatile("" : "+v"(tid));
        const int lane = tid & 63, wave = __builtin_amdgcn_readfirstlane(tid >> 6);
        const int gw = bx * 8 + wave, ngw = G * 8;
        const bool mix = (ph >= 4 && ph < 25);
        const int chunk = mix ? (ph - 4) / 7 : 0, mk = mix ? (ph - 4) % 7 : -1;
        const int S = (chunk == 2) ? 4096 : 2048, nseq = (chunk == 2) ? 4 : 8;
        const size_t crow0 = (size_t)chunk * CH;

        if (ph == 0) {
            LAS float* scr = (LAS float*)(lds + wave * 16384);
            convert_weight(args.in[6], DM, 2 * DFF, (bf16_t*)(ws + WS_W1U), DM, 0, true, scr, gw, ngw, lane);
            convert_weight(args.in[7], DFF, DM, (bf16_t*)(ws + WS_W1D), DFF, 0, false, scr, gw, ngw, lane);
            convert_weight(args.in[21], DM, 2 * DFF, (bf16_t*)(ws + WS_W2U), DM, 0, true, scr, gw, ngw, lane);
            convert_weight(args.in[22], DFF, DM, (bf16_t*)(ws + WS_W2D), DFF, 0, false, scr, gw, ngw, lane);
            convert_weight(args.in[11], DM, NIN, (bf16_t*)(ws + WS_WIN), DM, 0, false, scr, gw, ngw, lane);
            convert_weight(args.in[13], DM, NGT, (bf16_t*)(ws + WS_WG), DM, 0, false, scr, gw, ngw, lane);
            convert_weight(args.in[12], DM, DM, (bf16_t*)(ws + WS_WKV), DM, 0, false, scr, gw, ngw, lane);
            convert_weight(args.in[15], 512, DM, (bf16_t*)(ws + WS_WP), NAFM, 0, false, scr, gw, ngw, lane);
            convert_weight(args.in[16], 1024, DM, (bf16_t*)(ws + WS_WP), NAFM, 512, false, scr, gw, ngw, lane);
            convert_weight(args.in[17], 1024, DM, (bf16_t*)(ws + WS_WP), NAFM, 1536, false, scr, gw, ngw, lane);
            convert_weight(args.in[18], DM, DM, (bf16_t*)(ws + WS_WO), DM, 0, false, scr, gw, ngw, lane);
            for (int row = gw; row < TT; row += ngw) {
                const float* xr = (row < TP) ? args.in[0] + (size_t)row * DM : args.in[1] + (size_t)(row - TP) * DM;
                row_op(nullptr, xr, nullptr, XN + (size_t)row * DM, nullptr, args.in[5], 0.f, lane);
            }
        }
#ifndef DIS_G1
        if (ph == 1 || ph == 25) {
            SchedStd Sd; Sd.so.init(TT, 2 * DFF, G, bx); Sd.A = (const char*)XN; Sd.B = (const char*)(ws + (ph == 1 ? WS_W1U : WS_W2U)); Sd.C = Hb;
            Sd.a_tile = (size_t)256 * DM * 2; Sd.b_tile = (size_t)256 * DM * 2; Sd.ldc = DFF; Sd.ccols = 128; Sd.nt = DM / 64;
            pg8::EpiSwiGLU E{DFF};
            pg8::gemm_phase<pg8::EpiSwiGLU, SchedStd>(lds, tid, DM, DM, Sd, E);
        }
#endif
#ifndef DIS_G2
        if (ph == 2 || ph == 26 || mk == 0 || mk == 5) {
            const int nrep = (ph == 4) ? 2 : 1;
            for (int rep = 0; rep < nrep; ++rep) {
                SchedStd Sd; int lda, ldb;
                if (ph == 2 || ph == 26) { Sd.so.init(TT, DM, G, bx); Sd.A = (const char*)Hb; Sd.B = (const char*)(ws + (ph == 2 ? WS_W1D : WS_W2D)); Sd.C = XN; lda = DFF; ldb = DFF; Sd.ldc = DM; Sd.nt = DFF / 64; }
                else if (mk == 0 && rep == 0) { Sd.so.init(CH, NIN, G, bx); Sd.A = (const char*)(XN + crow0 * DM); Sd.B = (const char*)(ws + WS_WIN); Sd.C = ZG; lda = DM; ldb = DM; Sd.ldc = NIN; Sd.nt = DM / 64; }
                else if (mk == 0) { Sd.so.init(5120, DM, G, bx); Sd.A = (const char*)MEMN; Sd.B = (const char*)(ws + WS_WKV); Sd.C = KV; lda = DM; ldb = DM; Sd.ldc = DM; Sd.nt = DM / 64; }
                else { Sd.so.init(CH, DM, G, bx); Sd.A = (const char*)ZG; Sd.B = (const char*)(ws + WS_WO); Sd.C = YT; lda = NGT; ldb = DM; Sd.ldc = DM; Sd.nt = DM / 64; }
                Sd.a_tile = (size_t)256 * lda * 2; Sd.b_tile = (size_t)256 * ldb * 2; Sd.ccols = 256;
                pg8::EpiStore<0> E{Sd.ldc, nullptr};
                pg8::gemm_phase<pg8::EpiStore<0>, SchedStd>(lds, tid, lda, ldb, Sd, E);
            }
        }
#endif
#ifndef DIS_R3
        if (ph == 3) {
            for (int row = gw; row < TT; row += ngw) {
                const float* xr = (row < TP) ? args.in[0] + (size_t)row * DM : args.in[1] + (size_t)(row - TP) * DM;
                row_op(XN + (size_t)row * DM, xr, out + (size_t)row * DM, XN + (size_t)row * DM, args.in[8], args.in[9], 0.5f, lane);
            }
            for (int row = gw; row < 5120; row += ngw) {
                const float* xr = (row < 4096) ? args.in[2] + (size_t)row * DM : args.in[3] + (size_t)(row - 4096) * DM;
                row_op(nullptr, xr, nullptr, MEMN + (size_t)row * DM, nullptr, args.in[10], 0.f, lane);
            }
            const int gt = bx * 512 + tid, ngt = G * 512;
            for (int which = 0; which < 2; ++which) {
                const int SS = which ? 4096 : 2048; bf16_t* DS = which ? DS4 : DS2; const float scl = which ? 0.015625f : 0.022097086912079608f; const float inv = 2.0f / (float)SS;
                const int per_row = (2 * SS) / 8, total = SS * per_row;
                for (int idx = gt; idx < total; idx += ngt) { const int j = idx / per_row, k8 = (idx - j * per_row) * 8; float vv[8];
#pragma unroll
                    for (int e = 0; e < 8; ++e) { const int k = k8 + e; const int kk = k & (SS - 1); const int mm = (j * kk) & (SS - 1); const float x = (float)mm * inv;
                        vv[e] = (k >= SS) ? -sinpif(x) * scl : cospif(x) * scl; }
                    u32x4 w; w.x = cvt_pk_bf16(vv[0], vv[1]); w.y = cvt_pk_bf16(vv[2], vv[3]); w.z = cvt_pk_bf16(vv[4], vv[5]); w.w = cvt_pk_bf16(vv[6], vv[7]);
                    *(u32x4*)(DS + (size_t)j * (2 * SS) + k8) = w; }
            }
            for (int idx = gt; idx < 512 * 256 / 8; idx += ngt) { const int mrow = idx / 32, c8 = (idx - mrow * 32) * 8; float vv[8];
#pragma unroll
                for (int e = 0; e < 8; ++e) { const int cc = c8 + e; const int mm = ((mrow & 255) * cc) & 255; const float x = (float)mm * (2.0f / 256.0f);
                    vv[e] = (mrow >= 256) ? sinpif(x) * 0.0625f : cospif(x) * 0.0625f; }
                u32x4 w; w.x = cvt_pk_bf16(vv[0], vv[1]); w.y = cvt_pk_bf16(vv[2], vv[3]); w.z = cvt_pk_bf16(vv[4], vv[5]); w.w = cvt_pk_bf16(vv[6], vv[7]);
                *(u32x4*)(D256 + (size_t)mrow * 256 + c8) = w; }
        }
#endif
#ifndef DIS_M1
        if (mk == 1) {
#ifndef DIS_F1
            { SchedF1 Sf{(const char*)D256, (const char*)ZG, YT, S, nseq * 4 * 2 * (S >> 8), G, bx};
              pg8::EpiStore<0> E{2 * S, nullptr};
              pg8::gemm_phase<pg8::EpiStore<0>, SchedF1>(lds, tid, 256, NIN, Sf, E); }
#endif
            LAS float* biasL = (LAS float*)lds;
#ifndef DIS_BIAS
            for (int idx = tid; idx < 12 * 129; idx += 512) { const int h12 = idx / 129, dd = idx - h12 * 129 - 64; const int g = h12 >> 2;
                biasL[h12 * 132 + dd + 64] = args.in[4][t5_bucket(dd * (1 << (2 * g))) * 12 + h12] * LOG2E; }
#endif
            __syncthreads();
#ifndef DIS_DIL
            for (int u = gw; u < 12 * 512; u += ngw) dil_attn_unit(ZG, LSE, biasL, S, u, lane);
#endif
#ifndef DIS_MEM
            for (int u = gw; u < 4 * 512; u += ngw) { const int w = u & 511; const int bglob = (chunk == 2 ? 16 : chunk * 8) + (w * 32) / S;
                mem_attn_unit(ZG, KV + (size_t)bglob * 256 * 2048, AFM, u, lane); }
#endif
            __syncthreads();
        }
#endif
#ifndef DIS_M2
        if (mk == 2) {
            { SchedF2 Sf{(const char*)(chunk == 2 ? DS4 : DS2), (const char*)YT, AFM, S, nseq * (S >> 8) * 4, G, bx};
              pg8::EpiStore<0> E{NAFM, nullptr};
              pg8::gemm_phase<pg8::EpiStore<0>, SchedF2>(lds, tid, 2 * S, 2 * S, Sf, E); }
            for (int t = gw; t < CH; t += ngw) { const int j = lane >> 4, e0 = (lane & 15) * 8;
                const float l0 = LSE[(size_t)t * 12 + j], l1 = LSE[(size_t)t * 12 + 4 + j], l2 = LSE[(size_t)t * 12 + 8 + j];
                const float mxl = fmaxf(l0, fmaxf(l1, l2)); float w0 = __builtin_amdgcn_exp2f(l0 - mxl), w1 = __builtin_amdgcn_exp2f(l1 - mxl), w2 = __builtin_amdgcn_exp2f(l2 - mxl);
                const float iw = 1.0f / (w0 + w1 + w2); w0 *= iw; w1 *= iw; w2 *= iw;
                const bf16_t* zr = ZG + (size_t)t * NIN + j * 128 + e0;
                const u32x4 a = *(const u32x4*)zr, b = *(const u32x4*)(zr + 512), c = *(const u32x4*)(zr + 1024);
                u32x4 o;
                o.x = cvt_pk_bf16(w0 * bf_lo(a.x) + w1 * bf_lo(b.x) + w2 * bf_lo(c.x), w0 * bf_hi(a.x) + w1 * bf_hi(b.x) + w2 * bf_hi(c.x));
                o.y = cvt_pk_bf16(w0 * bf_lo(a.y) + w1 * bf_lo(b.y) + w2 * bf_lo(c.y), w0 * bf_hi(a.y) + w1 * bf_hi(b.y) + w2 * bf_hi(c.y));
                o.z = cvt_pk_bf16(w0 * bf_lo(a.z) + w1 * bf_lo(b.z) + w2 * bf_lo(c.z), w0 * bf_hi(a.z) + w1 * bf_hi(b.z) + w2 * bf_hi(c.z));
                o.w = cvt_pk_bf16(w0 * bf_lo(a.w) + w1 * bf_lo(b.w) + w2 * bf_lo(c.w), w0 * bf_hi(a.w) + w1 * bf_hi(b.w) + w2 * bf_hi(c.w));
                *(u32x4*)(AFM + (size_t)t * NAFM + j * 128 + e0) = o; }
        }
#endif
#ifndef DIS_M3
        if (mk == 3) {
            SchedStd Sd; Sd.so.init(CH, NGT, G, bx); Sd.A = (const char*)(XN + crow0 * DM); Sd.B = (const char*)(ws + WS_WG); Sd.C = ZG;
            Sd.a_tile = (size_t)256 * DM * 2; Sd.b_tile = (size_t)256 * DM * 2; Sd.ldc = NGT; Sd.ccols = 256; Sd.nt = DM / 64;
            pg8::EpiStore<0> E{NGT, nullptr};
            pg8::gemm_phase<pg8::EpiStore<0>, SchedStd>(lds, tid, DM, DM, Sd, E);
        }
#endif
#ifndef DIS_M4
        if (mk == 4) {
            SchedP Sp; Sp.so.init(CH, DM, G, bx); Sp.AFM = (const char*)AFM; Sp.WP = (const char*)(ws + WS_WP); Sp.Gc = ZG;
            pg8::EpiGateRMW E{NGT, args.in[14]};
            pg8::gemm_phase<pg8::EpiGateRMW, SchedP>(lds, tid, NAFM, NAFM, Sp, E);
        }
#endif
#ifndef DIS_R6
        if (mk == 6 || ph == 27) {
            const int r0 = (ph == 27) ? 0 : (int)crow0, nr = (ph == 27) ? TT : CH;
            for (int row = gw; row < nr; row += ngw) { const size_t gr = (size_t)(r0 + row);
                const bf16_t* yr = (ph == 27) ? XN + gr * DM : YT + (size_t)row * DM;
                row_op(yr, out + gr * DM, out + gr * DM, (ph == 27) ? nullptr : XN + gr * DM, (ph == 27 ? args.in[23] : args.in[19]), args.in[20], ph == 27 ? 0.5f : 1.0f, lane); }
        }
#endif

#if MK_COOP
        if (ph + 1 < args.ph_hi) grid.sync();
#endif
    }
}

extern "C" void kernel_launch(void* const* d_in, const int* in_sizes, int n_in, void* d_out, int out_size, void* d_ws, size_t ws_size, hipStream_t stream) {
    static int grid = 0;
    if (grid == 0) {
        if (n_in != 24 || out_size != TT * DM || ws_size < WS_END) { fprintf(stderr, "kernel_launch: unexpected shapes (n_in %d out %d ws %zu)\n", n_in, out_size, ws_size); grid = -1; return; }
        int dev = 0, cus = 0, per_cu = 0;
        hipGetDevice(&dev); hipDeviceGetAttribute(&cus, hipDeviceAttributeMultiprocessorCount, dev);
        if (hipFuncSetAttribute((const void*)mk_fwd, hipFuncAttributeMaxDynamicSharedMemorySize, LDS_BYTES) != hipSuccess) { fprintf(stderr, "kernel_launch: hipFuncSetAttribute failed\n"); grid = -1; return; }
        if (hipOccupancyMaxActiveBlocksPerMultiprocessor(&per_cu, (const void*)mk_fwd, 512, LDS_BYTES) != hipSuccess || per_cu < 1) { fprintf(stderr, "kernel_launch: occupancy query says %d\n", per_cu); per_cu = 1; }
        (void)hipGetLastError();
        grid = cus * 1;
    }
    if (grid < 0) return;
    Args a{};
    for (int i = 0; i < 24; ++i) a.in[i] = (const float*)d_in[i];
    a.out = (float*)d_out; a.ws = (unsigned char*)d_ws;
#if MK_COOP
    a.ph_lo = 0; a.ph_hi = N_PHASES; a.coop = 1;
    void* kargs[] = {&a};
    hipError_t e = hipLaunchCooperativeKernel((const void*)mk_fwd, dim3(grid), dim3(512), kargs, LDS_BYTES, stream);
    if (e != hipSuccess) fprintf(stderr, "cooperative launch failed: %s (grid %d)\n", hipGetErrorString(e), grid);
#else
    for (int ph = 0; ph < N_PHASES; ++ph) {
        a.ph_lo = ph; a.ph_hi = ph + 1; a.coop = 0;
        hipLaunchKernelGGL(mk_fwd, dim3(grid), dim3(512), LDS_BYTES, stream, a);
    }
#endif
}
```

```cpp
#include <hip/hip_runtime.h>
#include <hip/hip_cooperative_groups.h>
#include <cstdio>
#include <cstdint>
namespace cg = cooperative_groups;

#ifndef MK_COOP
#define MK_COOP 1
#endif

#define LAS __attribute__((address_space(3)))
typedef unsigned short bf16_t;
typedef short bf16x8 __attribute__((ext_vector_type(8)));
typedef float f32x4 __attribute__((ext_vector_type(4)));
typedef float f32x16 __attribute__((ext_vector_type(16)));
typedef unsigned u32x4 __attribute__((ext_vector_type(4)));
typedef unsigned u32x2 __attribute__((ext_vector_type(2)));

constexpr int TT = 49152, DM = 2048, DFF = 5632, NIN = 6656, NGT = 6144, CH = 16384, NAFM = 2560;
constexpr int TP = 32768;
constexpr float RMS_EPS = 1e-6f;
constexpr float LOG2E = 1.4426950408889634f;
constexpr size_t MiB = 1u << 20;
constexpr size_t WS_W1U = 1 * MiB;
constexpr size_t WS_W1D = WS_W1U + 44 * MiB;
constexpr size_t WS_W2U = WS_W1D + 22 * MiB;
constexpr size_t WS_W2D = WS_W2U + 44 * MiB;
constexpr size_t WS_WIN = WS_W2D + 22 * MiB;
constexpr size_t WS_WG = WS_WIN + 26 * MiB;
constexpr size_t WS_WKV = WS_WG + 24 * MiB;
constexpr size_t WS_WP = WS_WKV + 8 * MiB;
constexpr size_t WS_WO = WS_WP + 10 * MiB;
constexpr size_t WS_XN = WS_WO + 8 * MiB;
constexpr size_t WS_H = WS_XN + 192 * MiB;
constexpr size_t WS_ZG = WS_H;
constexpr size_t WS_AFM = WS_ZG + 208 * MiB;
constexpr size_t WS_YT = WS_AFM + 80 * MiB;
constexpr size_t WS_LSE = WS_YT + 64 * MiB;
constexpr size_t WS_DS2 = WS_LSE + 1 * MiB;
constexpr size_t WS_DS4 = WS_DS2 + 16 * MiB;
constexpr size_t WS_D256 = WS_DS4 + 64 * MiB;
constexpr size_t WS_MEMN = WS_D256 + 1 * MiB;
constexpr size_t WS_KV = WS_MEMN + 20 * MiB;
constexpr size_t WS_END = WS_H + 528 * MiB;
static_assert(WS_KV + 20 * MiB <= WS_END, "overlay map");

constexpr int LDS_BYTES = 139264;

__device__ __forceinline__ unsigned cvt_pk_bf16(float lo, float hi) { unsigned r; asm volatile("v_cvt_pk_bf16_f32 %0, %1, %2" : "=v"(r) : "v"(lo), "v"(hi)); return r; }
__device__ __forceinline__ float bf_lo(unsigned u) { return __uint_as_float(u << 16); }
__device__ __forceinline__ float bf_hi(unsigned u) { return __uint_as_float(u & 0xffff0000u); }
__device__ __forceinline__ float wave_sum(float v) {
#pragma unroll
    for (int o = 1; o < 64; o <<= 1) v += __shfl_xor(v, o);
    return v;
}
__device__ __forceinline__ float sigmoidf_(float x) { return __builtin_amdgcn_rcpf(1.0f + __builtin_amdgcn_exp2f(-x * LOG2E)); }

namespace pg8 {
constexpr int BM = 256, BK = 64, HALF = 128, HTB = HALF * BK * 2, STAGE_BYTES = 8 * HTB, NXCD = 8, WGM = 8;
__host__ __device__ __forceinline__ int lds_byte(int r, int c) { const int st = (r >> 4) * 2 + (c >> 5), rr = r & 15, cc = c & 31, ob = rr * 64 + cc * 2; return st * 1024 + (ob ^ (((ob >> 9) & 1) << 5)); }
__host__ __device__ __forceinline__ void stage_rc(int b, int& R, int& C) { const int st = b / 1024, sb = b % 1024, swz = sb ^ (((sb >> 9) & 1) << 5); R = (st >> 1) * 16 + swz / 64; C = (st & 1) * 32 + (swz % 64) / 2; }
__host__ __device__ __forceinline__ int perm32(int rho) { const int n = rho >> 4, i = rho & 15; return 8 * (i >> 2) + 4 * n + (i & 3); }

struct Unit { const char* A; const char* B; bf16_t* C; const bf16_t* C2; int nt; int aux; };
struct PN { int pm, pn; };
struct StaticOrder {
    int nM, nN, nwg, G, c;
    __device__ void init(int M, int N, int G_, int c_) { nM = M / BM; nN = N / BM; nwg = nM * nN; G = G_; c = c_; }
    __device__ bool next(int i, PN& u) const {
        const long L = (long)i * G + c; if (L >= nwg) return false;
        int wgid = (int)L; { const int q = nwg / NXCD, r = nwg % NXCD, xcd = wgid % NXCD, off = wgid / NXCD; wgid = (xcd < r ? xcd * (q + 1) : r * (q + 1) + (xcd - r) * q) + off; }
        const int nig = WGM * nN, gid = wgid / nig, fm = gid * WGM, gsz = (nM - fm) < WGM ? (nM - fm) : WGM;
        u.pm = fm + ((wgid % nig) % gsz); u.pn = (wgid % nig) / gsz; return true;
    }
};

template <int ACT> struct EpiStore {
    int ldc; const float* bias;
    __device__ __forceinline__ void operator()(const f32x4 (&acc)[2][2][4][2], const Unit& u, int wr, int wc, int fr, int fq) const {
        bf16_t* base = u.C + (size_t)(wr * 64 + fr) * ldc + wc * 32 + 8 * fq;
        f32x4 bv[2][2];
        if (ACT == 1) {
#pragma unroll
            for (int bj = 0; bj < 2; ++bj)
#pragma unroll
                for (int n = 0; n < 2; ++n) bv[bj][n] = *(const f32x4*)(bias + u.aux + bj * HALF + wc * 32 + 8 * fq + 4 * n);
        }
#pragma unroll
        for (int ai = 0; ai < 2; ++ai)
#pragma unroll
            for (int m = 0; m < 4; ++m) { bf16_t* rowp = base + (size_t)(ai * HALF + m * 16) * ldc;
#pragma unroll
                for (int bj = 0; bj < 2; ++bj) { f32x4 v0 = acc[ai][bj][m][0], v1 = acc[ai][bj][m][1];
                    if (ACT == 1) { v0 = v0 + bv[bj][0]; v1 = v1 + bv[bj][1];
#pragma unroll
                        for (int e = 0; e < 4; ++e) { v0[e] = sigmoidf_(v0[e]); v1[e] = sigmoidf_(v1[e]); } }
                    u32x4 w; w.x = cvt_pk_bf16(v0[0], v0[1]); w.y = cvt_pk_bf16(v0[2], v0[3]); w.z = cvt_pk_bf16(v1[0], v1[1]); w.w = cvt_pk_bf16(v1[2], v1[3]);
                    *(u32x4*)(rowp + bj * HALF) = w; } }
    }
};
struct EpiSwiGLU {
    int ldc;
    __device__ __forceinline__ void operator()(const f32x4 (&acc)[2][2][4][2], const Unit& u, int wr, int wc, int fr, int fq) const {
        bf16_t* base = u.C + (size_t)(wr * 64 + fr) * ldc + wc * 32 + 8 * fq;
#pragma unroll
        for (int ai = 0; ai < 2; ++ai)
#pragma unroll
            for (int m = 0; m < 4; ++m) { bf16_t* rowp = base + (size_t)(ai * HALF + m * 16) * ldc;
                f32x4 v0, v1;
#pragma unroll
                for (int e = 0; e < 4; ++e) { const float a0 = acc[ai][0][m][0][e], a1 = acc[ai][0][m][1][e];
                    v0[e] = a0 * sigmoidf_(a0) * acc[ai][1][m][0][e]; v1[e] = a1 * sigmoidf_(a1) * acc[ai][1][m][1][e]; }
                u32x4 w; w.x = cvt_pk_bf16(v0[0], v0[1]); w.y = cvt_pk_bf16(v0[2], v0[3]); w.z = cvt_pk_bf16(v1[0], v1[1]); w.w = cvt_pk_bf16(v1[2], v1[3]);
                *(u32x4*)rowp = w; }
    }
};
struct EpiGateRMW {
    int ldc; const float* bias;
    __device__ __forceinline__ void operator()(const f32x4 (&acc)[2][2][4][2], const Unit& u, int wr, int wc, int fr, int fq) const {
        const size_t off0 = (size_t)(wr * 64 + fr) * ldc + wc * 32 + 8 * fq;
        f32x4 bv[2][2];
#pragma unroll
        for (int bj = 0; bj < 2; ++bj)
#pragma unroll
            for (int n = 0; n < 2; ++n) bv[bj][n] = *(const f32x4*)(bias + (u.aux >> 2) + bj * HALF + wc * 32 + 8 * fq + 4 * n);
#pragma unroll
        for (int ai = 0; ai < 2; ++ai)
#pragma unroll
            for (int m = 0; m < 4; ++m) { const size_t ro = off0 + (size_t)(ai * HALF + m * 16) * ldc;
#pragma unroll
                for (int bj = 0; bj < 2; ++bj) {
                    const u32x4 g = *(const u32x4*)(u.C2 + ro + bj * HALF);
                    u32x4 o = (u32x4){0u, 0u, 0u, 0u}; if (u.aux & 3) o = *(const u32x4*)(u.C + ro + bj * HALF);
                    const f32x4 a0 = acc[ai][bj][m][0], a1 = acc[ai][bj][m][1];
                    const f32x4 b0 = bv[bj][0], b1 = bv[bj][1];
                    u32x4 w;
                    w.x = cvt_pk_bf16(bf_lo(o.x) + sigmoidf_(bf_lo(g.x) + b0[0]) * a0[0], bf_hi(o.x) + sigmoidf_(bf_hi(g.x) + b0[1]) * a0[1]);
                    w.y = cvt_pk_bf16(bf_lo(o.y) + sigmoidf_(bf_lo(g.y) + b0[2]) * a0[2], bf_hi(o.y) + sigmoidf_(bf_hi(g.y) + b0[3]) * a0[3]);
                    w.z = cvt_pk_bf16(bf_lo(o.z) + sigmoidf_(bf_lo(g.z) + b1[0]) * a1[0], bf_hi(o.z) + sigmoidf_(bf_hi(g.z) + b1[1]) * a1[1]);
                    w.w = cvt_pk_bf16(bf_lo(o.w) + sigmoidf_(bf_lo(g.w) + b1[2]) * a1[2], bf_hi(o.w) + sigmoidf_(bf_hi(g.w) + b1[3]) * a1[3]);
                    *(u32x4*)(u.C + ro + bj * HALF) = w; } }
    }
};

template <class Epi, class Sched>
__device__ __forceinline__ void gemm_phase(LAS unsigned char* lds, const int tid, const int lda, const int ldb, const Sched& S, const Epi& E) {
    const int wid = __builtin_amdgcn_readfirstlane(tid >> 6), lane = tid & 63, wr = wid >> 2, wc = wid & 3, fr = lane & 15, fq = lane >> 4;
    unsigned voffA[2], voffB[2];
#pragma unroll
    for (int i = 0; i < 2; ++i) { int R, C; stage_rc(tid * 16 + i * 8192, R, C); const int Rb = (R & ~31) + perm32(R & 31);
        voffA[i] = (unsigned)(R * lda + C) * 2u; voffB[i] = (unsigned)(Rb * ldb + C) * 2u; }
    const size_t kstep = (size_t)(BK * 2);
    const size_t hstepA = (size_t)HALF * lda * 2, hstepB = (size_t)HALF * ldb * 2;
    const unsigned ldsw = (unsigned)wid * 1024u;
    const int aoff = lds_byte(wr * 64 + fr, fq * 8), boff = lds_byte(wc * 32 + fr, fq * 8);
#define PG8_SA(b, h) (((b) * 2 + (h)) * HTB)
#define PG8_SB(b, h) ((4 + (b) * 2 + (h)) * HTB)
#define PG8_STAGE(bufoff, gbase, voff) do { _Pragma("unroll") for (int _i = 0; _i < 2; ++_i) \
        __builtin_amdgcn_global_load_lds((const unsigned*)((const char*)(gbase) + (voff)[_i]), (LAS unsigned*)(lds + (bufoff) + ldsw + _i * 8192), 16, 0, 0); } while (0)
#define PG8_LDA(dst, b, h) do { _Pragma("unroll") for (int m = 0; m < 4; ++m) _Pragma("unroll") for (int k = 0; k < 2; ++k) dst[m][k] = *(const LAS bf16x8*)(lds + PG8_SA(b, h) + aoff + m * 2048 + k * 1024); } while (0)
#define PG8_LDB(dst, b, h) do { _Pragma("unroll") for (int n = 0; n < 2; ++n) _Pragma("unroll") for (int k = 0; k < 2; ++k) dst[n][k] = *(const LAS bf16x8*)(lds + PG8_SB(b, h) + boff + n * 2048 + k * 1024); } while (0)
#define PG8_MMA(ai, bj, At, Bt) do { __builtin_amdgcn_s_setprio(1); _Pragma("unroll") for (int m = 0; m < 4; ++m) _Pragma("unroll") for (int n = 0; n < 2; ++n) _Pragma("unroll") for (int k = 0; k < 2; ++k) \
        acc[ai][bj][m][n] = __builtin_amdgcn_mfma_f32_16x16x32_bf16(Bt[n][k], At[m][k], acc[ai][bj][m][n], 0, 0, 0); __builtin_amdgcn_s_setprio(0); } while (0)
#define PG8_WAIT_V(n) asm volatile("s_waitcnt vmcnt(" #n ")" ::: "memory")
#define PG8_WAIT_L(n) asm volatile("s_waitcnt lgkmcnt(" #n ")" ::: "memory")
#define PG8_BAR __builtin_amdgcn_s_barrier()
#define PG8_SCHED __builtin_amdgcn_sched_barrier(0)
    Unit cur, nxt; int ui = 0;
    if (!S.next(0, cur)) return;
    f32x4 acc[2][2][4][2];
#pragma unroll
    for (int a = 0; a < 2; ++a)
#pragma unroll
        for (int b = 0; b < 2; ++b)
#pragma unroll
            for (int m = 0; m < 4; ++m)
#pragma unroll
                for (int n = 0; n < 2; ++n) acc[a][b][m][n] = (f32x4){0.f, 0.f, 0.f, 0.f};
    bf16x8 At[4][2], B0[2][2], B1[2][2];
    const char* cA = cur.A; const char* cB = cur.B;
    PG8_STAGE(PG8_SB(0, 0), cB, voffB); PG8_STAGE(PG8_SB(0, 1), cB + hstepB, voffB); PG8_STAGE(PG8_SA(0, 0), cA, voffA); PG8_STAGE(PG8_SA(0, 1), cA + hstepA, voffA);
    if (wr == 1) PG8_BAR;
    PG8_WAIT_V(2); PG8_BAR;
    PG8_STAGE(PG8_SB(1, 0), cB + kstep, voffB); PG8_STAGE(PG8_SA(1, 0), cA + kstep, voffA); PG8_STAGE(PG8_SB(1, 1), cB + hstepB + kstep, voffB);
    PG8_WAIT_V(6); PG8_BAR;
    for (;;) {
        const bool has_next = S.next(ui + 1, nxt);
        const char* nA = has_next ? nxt.A : cA; const char* nB = has_next ? nxt.B : cB;
        int nt = cur.nt; asm volatile("" : "+s"(nt));
        for (int t = 0; t < nt; t += 2) {
            const bool last = (t == nt - 2);
            const char* a1 = cA + (size_t)(t + 1) * kstep;
            const char* a2 = last ? nA : cA + (size_t)(t + 2) * kstep; const char* b2 = last ? nB : cB + (size_t)(t + 2) * kstep;
            const char* a3 = a2 + kstep; const char* b3 = b2 + kstep;
            PG8_LDB(B0, 0, 0); PG8_LDB(B1, 0, 1); PG8_SCHED; PG8_LDA(At, 0, 0); PG8_STAGE(PG8_SA(1, 1), a1 + hstepA, voffA);
            PG8_WAIT_V(8); PG8_WAIT_L(0); PG8_BAR; PG8_MMA(0, 0, At, B0); PG8_MMA(0, 1, At, B1); PG8_BAR; PG8_SCHED;
            PG8_LDA(At, 0, 1); PG8_STAGE(PG8_SB(0, 0), b2, voffB); PG8_STAGE(PG8_SB(0, 1), b2 + hstepB, voffB); PG8_STAGE(PG8_SA(0, 0), a2, voffA);
            PG8_WAIT_V(8); PG8_WAIT_L(0); PG8_BAR; PG8_MMA(1, 0, At, B0); PG8_MMA(1, 1, At, B1); PG8_BAR; PG8_SCHED;
            PG8_LDB(B0, 1, 0); PG8_LDB(B1, 1, 1); PG8_SCHED; PG8_LDA(At, 1, 0); PG8_STAGE(PG8_SA(0, 1), a2 + hstepA, voffA);
            PG8_WAIT_V(8); PG8_WAIT_L(0); PG8_BAR; PG8_MMA(0, 0, At, B0); PG8_MMA(0, 1, At, B1); PG8_BAR; PG8_SCHED;
            PG8_LDA(At, 1, 1); PG8_STAGE(PG8_SB(1, 0), b3, voffB); PG8_STAGE(PG8_SB(1, 1), b3 + hstepB, voffB); PG8_STAGE(PG8_SA(1, 0), a3, voffA);
            PG8_WAIT_V(8); PG8_WAIT_L(0); PG8_BAR; PG8_MMA(1, 0, At, B0); PG8_MMA(1, 1, At, B1); PG8_BAR; PG8_SCHED;
        }
        if (wr == 0) PG8_BAR;
        E(acc, cur, wr, wc, fr, fq);
        if (!has_next) break;
#pragma unroll
        for (int a = 0; a < 2; ++a)
#pragma unroll
            for (int b = 0; b < 2; ++b)
#pragma unroll
                for (int m = 0; m < 4; ++m)
#pragma unroll
                    for (int n = 0; n < 2; ++n) acc[a][b][m][n] = (f32x4){0.f, 0.f, 0.f, 0.f};
        cur = nxt; cA = nA; cB = nB; ++ui;
        if (wr == 1) PG8_BAR;
    }
    PG8_WAIT_V(0);
    PG8_BAR;
#undef PG8_SA
#undef PG8_SB
#undef PG8_STAGE
#undef PG8_LDA
#undef PG8_LDB
#undef PG8_MMA
#undef PG8_WAIT_V
#undef PG8_WAIT_L
#undef PG8_BAR
#undef PG8_SCHED
}
}

struct SchedStd {
    pg8::StaticOrder so; const char* A; const char* B; bf16_t* C; size_t a_tile, b_tile; int ldc, ccols, nt;
    __device__ __forceinline__ bool next(int i, pg8::Unit& u) const {
        pg8::PN p; if (!so.next(i, p)) return false;
        u.A = A + (size_t)p.pm * a_tile; u.B = B + (size_t)p.pn * b_tile; u.C = C + (size_t)p.pm * 256 * ldc + (size_t)p.pn * ccols; u.C2 = nullptr; u.nt = nt; u.aux = p.pn * 256; return true; }
};
struct SchedF1 {
    const char* D; const char* Z; bf16_t* Yt; int S, nunits, G, c;
    __device__ __forceinline__ bool next(int i, pg8::Unit& u) const {
        const int L = i * G + c; if (L >= nunits) return false;
        const int lg = (S == 4096) ? 4 : 3; const int pn = L & ((1 << lg) - 1); int t = L >> lg; const int pm = t & 1; t >>= 1; const int g = t & 3; const int b = t >> 2;
        u.A = D + (size_t)pm * 256 * 256 * 2; u.B = Z + ((size_t)(b * S + pn * 256) * NIN + 4608 + g * 256) * 2;
        u.C = Yt + (size_t)(b * 1024 + g * 256) * (2 * S) + (size_t)pm * S + pn * 256; u.C2 = nullptr; u.nt = 4; u.aux = 0; return true; }
};
struct SchedF2 {
    const char* DS; const char* Yt; bf16_t* AFM; int S, nunits, G, c;
    __device__ __forceinline__ bool next(int i, pg8::Unit& u) const {
        const int L = i * G + c; if (L >= nunits) return false;
        const int lg = (S == 4096) ? 4 : 3; const int pn = L & 3; const int t = L >> 2; const int pm = t & ((1 << lg) - 1); const int b = t >> lg;
        u.A = DS + (size_t)pm * 256 * (2 * S) * 2; u.B = Yt + (size_t)(b * 1024 + pn * 256) * (2 * S) * 2;
        u.C = AFM + (size_t)(b * S + pm * 256) * NAFM + 512 + pn * 256; u.C2 = nullptr; u.nt = (2 * S) >> 6; u.aux = 0; return true; }
};
struct SchedP {
    pg8::StaticOrder so; const char* AFM; const char* WP; bf16_t* Gc;
    __device__ __forceinline__ bool next(int i, pg8::Unit& u) const {
        const int j = i / 3, b = i - 3 * j; pg8::PN p; if (!so.next(j, p)) return false;
        const int koff = (b == 0) ? 0 : (b == 1 ? 512 : 1536);
        u.A = AFM + ((size_t)p.pm * 256 * NAFM + koff) * 2; u.B = WP + ((size_t)p.pn * 256 * NAFM + koff) * 2;
        u.C = Gc + (size_t)p.pm * 256 * NGT + p.pn * 256; u.C2 = u.C + b * 2048; u.nt = (b == 0) ? 8 : 16; u.aux = b + 4 * (b * 2048 + p.pn * 256); return true; }
};

__device__ __forceinline__ void row_op(const bf16_t* y, const float* xin, float* xout, bf16_t* xn, const float* g_post, const float* g_pre, float cres, int lane) {
    float v[32];
#pragma unroll
    for (int j = 0; j < 4; ++j) { const int e0 = j * 512 + lane * 8; const f32x4 a = *(const f32x4*)(xin + e0), b = *(const f32x4*)(xin + e0 + 4);
#pragma unroll
        for (int e = 0; e < 4; ++e) { v[j * 8 + e] = a[e]; v[j * 8 + 4 + e] = b[e]; } }
    if (y) {
        float yv[32]; float ss = 0.f;
#pragma unroll
        for (int j = 0; j < 4; ++j) { const u32x4 w = *(const u32x4*)(y + j * 512 + lane * 8);
            yv[j * 8 + 0] = bf_lo(w.x); yv[j * 8 + 1] = bf_hi(w.x); yv[j * 8 + 2] = bf_lo(w.y); yv[j * 8 + 3] = bf_hi(w.y);
            yv[j * 8 + 4] = bf_lo(w.z); yv[j * 8 + 5] = bf_hi(w.z); yv[j * 8 + 6] = bf_lo(w.w); yv[j * 8 + 7] = bf_hi(w.w); }
#pragma unroll
        for (int i = 0; i < 32; ++i) ss += yv[i] * yv[i];
        ss = wave_sum(ss);
        const float rs = cres * (1.0f / sqrtf(ss * (1.0f / DM) + RMS_EPS));
#pragma unroll
        for (int j = 0; j < 4; ++j) { const int e0 = j * 512 + lane * 8; const f32x4 a = *(const f32x4*)(g_post + e0), b = *(const f32x4*)(g_post + e0 + 4);
#pragma unroll
            for (int e = 0; e < 4; ++e) { v[j * 8 + e] += yv[j * 8 + e] * rs * a[e]; v[j * 8 + 4 + e] += yv[j * 8 + 4 + e] * rs * b[e]; } }
    }
    if (xout) {
#pragma unroll
        for (int j = 0; j < 4; ++j) { const int e0 = j * 512 + lane * 8;
            *(f32x4*)(xout + e0) = (f32x4){v[j * 8 + 0], v[j * 8 + 1], v[j * 8 + 2], v[j * 8 + 3]};
            *(f32x4*)(xout + e0 + 4) = (f32x4){v[j * 8 + 4], v[j * 8 + 5], v[j * 8 + 6], v[j * 8 + 7]}; }
    }
    if (xn) {
        float ss = 0.f;
#pragma unroll
        for (int i = 0; i < 32; ++i) ss += v[i] * v[i];
        ss = wave_sum(ss);
        const float rs = 1.0f / sqrtf(ss * (1.0f / DM) + RMS_EPS);
#pragma unroll
        for (int j = 0; j < 4; ++j) { const int e0 = j * 512 + lane * 8; const f32x4 a = *(const f32x4*)(g_pre + e0), b = *(const f32x4*)(g_pre + e0 + 4);
            u32x4 w; w.x = cvt_pk_bf16(v[j * 8 + 0] * rs * a[0], v[j * 8 + 1] * rs * a[1]); w.y = cvt_pk_bf16(v[j * 8 + 2] * rs * a[2], v[j * 8 + 3] * rs * a[3]);
            w.z = cvt_pk_bf16(v[j * 8 + 4] * rs * b[0], v[j * 8 + 5] * rs * b[1]); w.w = cvt_pk_bf16(v[j * 8 + 6] * rs * b[2], v[j * 8 + 7] * rs * b[3]);
            *(u32x4*)(xn + e0) = w; }
    }
}

__device__ __forceinline__ void transpose_item(const float* W, int N, bf16_t* WT, int ldk, int koff, int row_off, int k0, int n0, LAS float* scr, int lane) {
#pragma unroll 8
    for (int i = 0; i < 32; ++i) { const int kk = 2 * i + (lane >> 5); scr[kk * 33 + (lane & 31)] = W[(size_t)(k0 + kk) * N + n0 + (lane & 31)]; }
    asm volatile("s_waitcnt lgkmcnt(0)" ::: "memory");
    const int c = lane & 7;
#pragma unroll
    for (int j = 0; j < 4; ++j) { const int n = (lane >> 3) + 8 * j; const LAS float* s = scr + (8 * c) * 33 + n;
        u32x4 o; o.x = cvt_pk_bf16(s[0 * 33], s[1 * 33]); o.y = cvt_pk_bf16(s[2 * 33], s[3 * 33]); o.z = cvt_pk_bf16(s[4 * 33], s[5 * 33]); o.w = cvt_pk_bf16(s[6 * 33], s[7 * 33]);
        *(u32x4*)(WT + (size_t)(row_off + n) * ldk + koff + k0 + 8 * c) = o; }
    asm volatile("s_waitcnt lgkmcnt(0)" ::: "memory");
}
__device__ __forceinline__ void convert_weight(const float* W, int K, int N, bf16_t* WT, int ldk, int koff, bool swiglu_perm, LAS float* scr, int gw, int ngw, int lane) {
    const int nblk = N / 32, nitems = (K / 64) * nblk;
    for (int it = gw; it < nitems; it += ngw) {
        const int kb = it / nblk, nb = it - kb * nblk, n0 = nb * 32;
        int row_off = n0;
        if (swiglu_perm) { const int half = (n0 >= DFF) ? 1 : 0; const int n1 = n0 - half * DFF; row_off = (n1 >> 7) * 256 + half * 128 + (n1 & 127); }
        transpose_item(W, N, WT, ldk, koff, row_off - 0, kb * 64, n0, scr, lane);
    }
}

__device__ __forceinline__ int crow(int r, int hi) { return (r & 3) + 8 * (r >> 2) + 4 * hi; }
__device__ __forceinline__ bf16x8 pack8(const f32x16& s, int b) {
    u32x4 w; w.x = cvt_pk_bf16(s[b + 0], s[b + 1]); w.y = cvt_pk_bf16(s[b + 2], s[b + 3]); w.z = cvt_pk_bf16(s[b + 4], s[b + 5]); w.w = cvt_pk_bf16(s[b + 6], s[b + 7]);
    return __builtin_bit_cast(bf16x8, w);
}
__device__ __forceinline__ void dil_attn_unit(bf16_t* z, float* lse, const LAS float* biasL, int S, int unit, int lane) {
    const int h12 = unit >> 9, w = unit & 511;
    const int g = h12 >> 2, sh = 2 * g, L = S >> sh;
    const int spb = S >> 5; const int b = w / spb, v = w - b * spb; const int nlb = L >> 5; const int r = v / nlb, lb = v - r * nlb; const int l0 = lb * 32;
    const int q = lane & 31, hi = lane >> 5; const int lq = l0 + q;
    const size_t seqbase = (size_t)b * S;
    bf16_t* qrow = z + (seqbase + ((size_t)lq << sh) + r) * NIN + h12 * 128;
    bf16x8 qf[8];
#pragma unroll
    for (int ks = 0; ks < 8; ++ks) qf[ks] = *(const bf16x8*)(qrow + ks * 16 + hi * 8);
    f32x16 o[4];
#pragma unroll
    for (int dt = 0; dt < 4; ++dt)
#pragma unroll
        for (int i = 0; i < 16; ++i) o[dt][i] = 0.f;
    float m = -1e30f, lsum = 0.f;
    const float sc = 0.08838834764831845f * LOG2E;
    const LAS float* bl = biasL + h12 * 132 + 64;
    for (int kt = 0; kt < 5; ++kt) {
        const int kl0 = l0 - 64 + kt * 32;
        if (kl0 + 31 < 0 || kl0 >= L) continue;
        int kl = kl0 + q; kl = kl < 0 ? 0 : (kl > L - 1 ? L - 1 : kl);
        const bf16_t* kp = z + (seqbase + ((size_t)kl << sh) + r) * NIN + 1536 + h12 * 128 + hi * 8;
        f32x16 s;
#pragma unroll
        for (int i = 0; i < 16; ++i) s[i] = 0.f;
#pragma unroll
        for (int ks = 0; ks < 8; ++ks) { const bf16x8 kf = *(const bf16x8*)(kp + ks * 16); s = __builtin_amdgcn_mfma_f32_32x32x16_bf16(kf, qf[ks], s, 0, 0, 0); }
        float mx = -1e30f;
#pragma unroll
        for (int i = 0; i < 16; ++i) { const int lk = kl0 + crow(i, hi); const int dl = lk - lq; const bool valid = (dl >= -64) && (dl <= 64) && (lk >= 0) && (lk < L);
            const int di = dl < -64 ? -64 : (dl > 64 ? 64 : dl);
            const float vv = valid ? (s[i] * sc + bl[di]) : -1e30f; s[i] = vv; mx = fmaxf(mx, vv); }
        mx = fmaxf(mx, __shfl_xor(mx, 32));
        const float mn = fmaxf(m, mx); const float f = __builtin_amdgcn_exp2f(m - mn); m = mn;
        float ps = 0.f;
#pragma unroll
        for (int i = 0; i < 16; ++i) { const float p = __builtin_amdgcn_exp2f(s[i] - mn); s[i] = p; ps += p; }
        lsum = lsum * f + ps;
#pragma unroll
        for (int dt = 0; dt < 4; ++dt)
#pragma unroll
            for (int i = 0; i < 16; ++i) o[dt][i] *= f;
        const bf16x8 pa0 = pack8(s, 0), pa1 = pack8(s, 8);
#pragma unroll
        for (int s_ = 0; s_ < 2; ++s_) {
            u32x2 vv[8];
#pragma unroll
            for (int i = 0; i < 8; ++i) { int lk = kl0 + crow(8 * s_ + i, hi); lk = lk < 0 ? 0 : (lk > L - 1 ? L - 1 : lk);
                vv[i] = *(const u32x2*)(z + (seqbase + ((size_t)lk << sh) + r) * NIN + 3072 + h12 * 128 + 4 * q); }
#pragma unroll
            for (int dt = 0; dt < 4; ++dt) { u32x4 w;
                const unsigned sel = (dt & 1) ? 0x07060302u : 0x05040100u;
                if (dt < 2) { w.x = __builtin_amdgcn_perm(vv[1].x, vv[0].x, sel); w.y = __builtin_amdgcn_perm(vv[3].x, vv[2].x, sel); w.z = __builtin_amdgcn_perm(vv[5].x, vv[4].x, sel); w.w = __builtin_amdgcn_perm(vv[7].x, vv[6].x, sel); }
                else        { w.x = __builtin_amdgcn_perm(vv[1].y, vv[0].y, sel); w.y = __builtin_amdgcn_perm(vv[3].y, vv[2].y, sel); w.z = __builtin_amdgcn_perm(vv[5].y, vv[4].y, sel); w.w = __builtin_amdgcn_perm(vv[7].y, vv[6].y, sel); }
                o[dt] = __builtin_amdgcn_mfma_f32_32x32x16_bf16(__builtin_bit_cast(bf16x8, w), s_ ? pa1 : pa0, o[dt], 0, 0, 0); }
        }
    }
    lsum += __shfl_xor(lsum, 32);
    const float inv = 1.0f / lsum;
#pragma unroll
    for (int rg = 0; rg < 4; ++rg) {
        u32x4 w0, w1;
        w0.x = cvt_pk_bf16(o[0][4 * rg + 0] * inv, o[1][4 * rg + 0] * inv); w0.y = cvt_pk_bf16(o[2][4 * rg + 0] * inv, o[3][4 * rg + 0] * inv);
        w0.z = cvt_pk_bf16(o[0][4 * rg + 1] * inv, o[1][4 * rg + 1] * inv); w0.w = cvt_pk_bf16(o[2][4 * rg + 1] * inv, o[3][4 * rg + 1] * inv);
        w1.x = cvt_pk_bf16(o[0][4 * rg + 2] * inv, o[1][4 * rg + 2] * inv); w1.y = cvt_pk_bf16(o[2][4 * rg + 2] * inv, o[3][4 * rg + 2] * inv);
        w1.z = cvt_pk_bf16(o[0][4 * rg + 3] * inv, o[1][4 * rg + 3] * inv); w1.w = cvt_pk_bf16(o[2][4 * rg + 3] * inv, o[3][4 * rg + 3] * inv);
        *(u32x4*)(qrow + 32 * rg + 16 * hi) = w0; *(u32x4*)(qrow + 32 * rg + 16 * hi + 8) = w1; }
    if (hi == 0) lse[(seqbase + ((size_t)lq << sh) + r) * 12 + h12] = m + log2f(lsum);
}
__device__ __forceinline__ void mem_attn_unit(const bf16_t* z, const bf16_t* KVb, bf16_t* afm, int unit, int lane) {
    const int h = unit >> 9, w = unit & 511;
    const int q = lane & 31, hi = lane >> 5;
    const bf16_t* qp = z + (size_t)(w * 32 + q) * NIN + 5632 + h * 256 + hi * 8;
    f32x16 o[8];
#pragma unroll
    for (int dt = 0; dt < 8; ++dt)
#pragma unroll
        for (int i = 0; i < 16; ++i) o[dt][i] = 0.f;
    float m = -1e30f, lsum = 0.f;
    const float sc = 0.0625f * LOG2E;
    for (int kt = 0; kt < 8; ++kt) {
        const bf16_t* kp = KVb + (size_t)(kt * 32 + q) * 2048 + h * 256 + hi * 8;
        f32x16 s;
#pragma unroll
        for (int i = 0; i < 16; ++i) s[i] = 0.f;
#pragma unroll
        for (int ks = 0; ks < 16; ++ks) { const bf16x8 kf = *(const bf16x8*)(kp + ks * 16); const bf16x8 qf = *(const bf16x8*)(qp + ks * 16); s = __builtin_amdgcn_mfma_f32_32x32x16_bf16(kf, qf, s, 0, 0, 0); }
        float mx = -1e30f;
#pragma unroll
        for (int i = 0; i < 16; ++i) { s[i] *= sc; mx = fmaxf(mx, s[i]); }
        mx = fmaxf(mx, __shfl_xor(mx, 32));
        const float mn = fmaxf(m, mx); const float f = __builtin_amdgcn_exp2f(m - mn); m = mn;
        float ps = 0.f;
#pragma unroll
        for (int i = 0; i < 16; ++i) { const float p = __builtin_amdgcn_exp2f(s[i] - mn); s[i] = p; ps += p; }
        lsum = lsum * f + ps;
#pragma unroll
        for (int dt = 0; dt < 8; ++dt)
#pragma unroll
            for (int i = 0; i < 16; ++i) o[dt][i] *= f;
        const bf16x8 pa0 = pack8(s, 0), pa1 = pack8(s, 8);
#pragma unroll
        for (int s_ = 0; s_ < 2; ++s_) {
            const bf16_t* vb = KVb + (size_t)(kt * 32) * 2048 + 1024 + h * 256 + 8 * q;
            u32x4 vv[8];
#pragma unroll
            for (int i = 0; i < 8; ++i) vv[i] = *(const u32x4*)(vb + (size_t)crow(8 * s_ + i, hi) * 2048);
#pragma unroll
            for (int dt = 0; dt < 8; ++dt) { u32x4 w;
                const unsigned sel = (dt & 1) ? 0x07060302u : 0x05040100u; const int c = dt >> 1;
                w.x = __builtin_amdgcn_perm(vv[1][c], vv[0][c], sel); w.y = __builtin_amdgcn_perm(vv[3][c], vv[2][c], sel); w.z = __builtin_amdgcn_perm(vv[5][c], vv[4][c], sel); w.w = __builtin_amdgcn_perm(vv[7][c], vv[6][c], sel);
                o[dt] = __builtin_amdgcn_mfma_f32_32x32x16_bf16(__builtin_bit_cast(bf16x8, w), s_ ? pa1 : pa0, o[dt], 0, 0, 0); }
        }
    }
    lsum += __shfl_xor(lsum, 32);
    const float inv = 1.0f / lsum;
    bf16_t* op = afm + (size_t)(w * 32 + q) * NAFM + 1536 + h * 256;
#pragma unroll
    for (int r = 0; r < 16; ++r) {
        u32x4 w; w.x = cvt_pk_bf16(o[0][r] * inv, o[1][r] * inv); w.y = cvt_pk_bf16(o[2][r] * inv, o[3][r] * inv); w.z = cvt_pk_bf16(o[4][r] * inv, o[5][r] * inv); w.w = cvt_pk_bf16(o[6][r] * inv, o[7][r] * inv);
        *(u32x4*)(op + 8 * crow(r, hi)) = w; }
}

__device__ __forceinline__ int t5_bucket(int rel) {
    const int n = rel < 0 ? -rel : rel; const float nf = (float)(n < 1 ? 1 : n);
    int large = 8 + (int)(logf(nf / 8.0f) / 4.852030263919617f * 8.0f); large = large < 15 ? large : 15;
    return (rel > 0 ? 16 : 0) + (n < 8 ? n : large);
}


#define XB_TMO      128
#define XB_XCNT(j)  (256  + 64 * (j))
#define XB_XSUB(j)  (1280 + 64 * (j))
#define XB_XGEN(j)  (2304 + 64 * (j))
#define XB_TOP      3328
#define XB_TOPGEN   3392
#define XCD_BAR_WORDS 3456
#define XB_SPIN_CAP (1u << 22)
__device__ __forceinline__ unsigned xb_ld(unsigned* p)              { return __hip_atomic_load(p, __ATOMIC_RELAXED, __HIP_MEMORY_SCOPE_AGENT); }
__device__ __forceinline__ unsigned xb_add(unsigned* p, unsigned v) { return __hip_atomic_fetch_add(p, v, __ATOMIC_RELAXED, __HIP_MEMORY_SCOPE_AGENT); }
__device__ __forceinline__ unsigned xb_xcc_id() { return (unsigned)__builtin_amdgcn_s_getreg((3 << 11) | 20) & 0xFu; }
#define XB_SPIN(cond, bar) do { unsigned _sp = 0; while (cond) { __builtin_amdgcn_s_sleep(1); \
    if ((++_sp & 255u) == 0u) { if (xb_ld(&(bar)[XB_TMO])) break; if (_sp > XB_SPIN_CAP) { atomicAdd(&(bar)[XB_TMO], 1u); break; } } } } while (0)
struct XcdBarrier { unsigned* bar; unsigned x; volatile LAS unsigned* st; };
__device__ __forceinline__ XcdBarrier xcd_barrier_post(unsigned* bar, volatile LAS unsigned* st) {
    XcdBarrier b; b.bar = bar; b.x = xb_xcc_id(); b.st = st;
    if (threadIdx.x == 0) (void)xb_add(&bar[XB_XCNT(b.x)], 1u);
    return b;
}
__device__ __forceinline__ void xcd_barrier_complete(unsigned* bar, unsigned x, unsigned& nloc, unsigned& nx) {
    const unsigned G = gridDim.x * gridDim.y * gridDim.z;
    unsigned sum, cnt, mine, sp = 0u;
    for (;;) {
        sum = 0u; cnt = 0u; mine = 0u;
#pragma unroll
        for (unsigned j = 0; j < 16; ++j) { const unsigned c = xb_ld(&bar[XB_XCNT(j)]); sum += c; cnt += (c > 0u) ? 1u : 0u; mine = (j == x) ? c : mine; }
        if (sum == G) break;
        __builtin_amdgcn_s_sleep(1);
        if ((++sp & 255u) == 0u) { if (xb_ld(&bar[XB_TMO])) break; if (sp > XB_SPIN_CAP) { atomicAdd(&bar[XB_TMO], 1u); break; } }
    }
    nloc = mine > 0u ? mine : 1u; nx = cnt > 0u ? cnt : 1u;
}
__device__ __forceinline__ void xcd_barrier(const XcdBarrier& b) {
    asm volatile("s_waitcnt vmcnt(0)" ::: "memory");
    __syncthreads();
    if (threadIdx.x == 0) {
        unsigned* bar = b.bar;
        __builtin_amdgcn_s_waitcnt(0);
        unsigned nloc = b.st[0], nx = b.st[1];
        if (nloc == 0u) { xcd_barrier_complete(bar, b.x, nloc, nx); b.st[0] = nloc; b.st[1] = nx; }
        const unsigned old = xb_add(&bar[XB_XSUB(b.x)], 1u);
        const unsigned gen = old / nloc;
        if (old + 1u == (gen + 1u) * nloc) {
            __builtin_amdgcn_fence(__ATOMIC_RELEASE, "agent");
            asm volatile("s_waitcnt vmcnt(0)" ::: "memory");
            const unsigned og = xb_add(&bar[XB_TOP], 1u);
            const unsigned tg = og / nx;
            if (og + 1u == (tg + 1u) * nx) xb_add(&bar[XB_TOPGEN], 1u);
            else XB_SPIN(xb_ld(&bar[XB_TOPGEN]) == tg, bar);
            __builtin_amdgcn_fence(__ATOMIC_ACQUIRE, "agent");
            xb_add(&bar[XB_XGEN(b.x)], 1u);
            asm volatile("s_waitcnt vmcnt(0)" ::: "memory");
        } else {
            XB_SPIN(xb_ld(&bar[XB_XGEN(b.x)]) == gen, bar);
            __builtin_amdgcn_fence(__ATOMIC_ACQUIRE, "agent");
            asm volatile("s_waitcnt vmcnt(0)" ::: "memory");
        }
    }
    __syncthreads();
}

struct Args { const float* in[24]; float* out; unsigned char* ws; int ph_lo, ph_hi, coop, pad; };
constexpr int N_PHASES = 28;

__global__ void __launch_bounds__(512, 2) mk_fwd(Args args) {
    extern __shared__ __attribute__((aligned(16))) unsigned char lds_raw[];
    LAS unsigned char* lds = (LAS unsigned char*)lds_raw;
    const int G = gridDim.x, bx = blockIdx.x;
    unsigned char* ws = args.ws;
    float* out = args.out;
    bf16_t* XN = (bf16_t*)(ws + WS_XN); bf16_t* Hb = (bf16_t*)(ws + WS_H);
    bf16_t* ZG = (bf16_t*)(ws + WS_ZG); bf16_t* AFM = (bf16_t*)(ws + WS_AFM); bf16_t* YT = (bf16_t*)(ws + WS_YT); float* LSE = (float*)(ws + WS_LSE);
    bf16_t* DS2 = (bf16_t*)(ws + WS_DS2); bf16_t* DS4 = (bf16_t*)(ws + WS_DS4); bf16_t* D256 = (bf16_t*)(ws + WS_D256);
    bf16_t* MEMN = (bf16_t*)(ws + WS_MEMN); bf16_t* KV = (bf16_t*)(ws + WS_KV);
#if MK_COOP
    cg::grid_group grid = cg::this_grid();
    volatile LAS unsigned* xst = (volatile LAS unsigned*)(lds + 131072 + 64);
    if (threadIdx.x < 2) xst[threadIdx.x] = 0u;
    __syncthreads();
    const XcdBarrier xbar = xcd_barrier_post((unsigned*)ws, xst);
#endif

#ifndef PROBE_DUP
#define PROBE_DUP 1000
#endif
    for (int pi = args.ph_lo; pi < args.ph_hi; ++pi) {
        const int ph = (pi <= PROBE_DUP) ? pi : pi - 1;
        int tid = threadIdx.x; asm volatile("" : "+v"(tid));
        const int lane = tid & 63, wave = __builtin_amdgcn_readfirstlane(tid >> 6);
        const int gw = bx * 8 + wave, ngw = G * 8;
        const bool mix = (ph >= 4 && ph < 25);
        const int chunk = mix ? (ph - 4) / 7 : 0, mk = mix ? (ph - 4) % 7 : -1;
        const int S = (chunk == 2) ? 4096 : 2048, nseq = (chunk == 2) ? 4 : 8;
        const size_t crow0 = (size_t)chunk * CH;

        if (ph == 0) {
            LAS float* scr = (LAS float*)(lds + wave * 16384);
            convert_weight(args.in[6], DM, 2 * DFF, (bf16_t*)(ws + WS_W1U), DM, 0, true, scr, gw, ngw, lane);
            convert_weight(args.in[7], DFF, DM, (bf16_t*)(ws + WS_W1D), DFF, 0, false, scr, gw, ngw, lane);
            convert_weight(args.in[21], DM, 2 * DFF, (bf16_t*)(ws + WS_W2U), DM, 0, true, scr, gw, ngw, lane);
            convert_weight(args.in[22], DFF, DM, (bf16_t*)(ws + WS_W2D), DFF, 0, false, scr, gw, ngw, lane);
            convert_weight(args.in[11], DM, NIN, (bf16_t*)(ws + WS_WIN), DM, 0, false, scr, gw, ngw, lane);
            convert_weight(args.in[13], DM, NGT, (bf16_t*)(ws + WS_WG), DM, 0, false, scr, gw, ngw, lane);
            convert_weight(args.in[12], DM, DM, (bf16_t*)(ws + WS_WKV), DM, 0, false, scr, gw, ngw, lane);
            convert_weight(args.in[15], 512, DM, (bf16_t*)(ws + WS_WP), NAFM, 0, false, scr, gw, ngw, lane);
            convert_weight(args.in[16], 1024, DM, (bf16_t*)(ws + WS_WP), NAFM, 512, false, scr, gw, ngw, lane);
            convert_weight(args.in[17], 1024, DM, (bf16_t*)(ws + WS_WP), NAFM, 1536, false, scr, gw, ngw, lane);
            convert_weight(args.in[18], DM, DM, (bf16_t*)(ws + WS_WO), DM, 0, false, scr, gw, ngw, lane);
            for (int row = gw; row < TT; row += ngw) {
                const float* xr = (row < TP) ? args.in[0] + (size_t)row * DM : args.in[1] + (size_t)(row - TP) * DM;
                row_op(nullptr, xr, nullptr, XN + (size_t)row * DM, nullptr, args.in[5], 0.f, lane);
            }
        }
#ifndef DIS_G1
        if (ph == 1 || ph == 25) {
            SchedStd Sd; Sd.so.init(TT, 2 * DFF, G, bx); Sd.A = (const char*)XN; Sd.B = (const char*)(ws + (ph == 1 ? WS_W1U : WS_W2U)); Sd.C = Hb;
            Sd.a_tile = (size_t)256 * DM * 2; Sd.b_tile = (size_t)256 * DM * 2; Sd.ldc = DFF; Sd.ccols = 128; Sd.nt = DM / 64;
            pg8::EpiSwiGLU E{DFF};
            pg8::gemm_phase<pg8::EpiSwiGLU, SchedStd>(lds, tid, DM, DM, Sd, E);
        }
#endif
#ifndef DIS_G2
        if (ph == 2 || ph == 26 || mk == 0 || mk == 5) {
            const int nrep = (ph == 4) ? 2 : 1;
            for (int rep = 0; rep < nrep; ++rep) {
                SchedStd Sd; int lda, ldb;
                if (ph == 2 || ph == 26) { Sd.so.init(TT, DM, G, bx); Sd.A = (const char*)Hb; Sd.B = (const char*)(ws + (ph == 2 ? WS_W1D : WS_W2D)); Sd.C = XN; lda = DFF; ldb = DFF; Sd.ldc = DM; Sd.nt = DFF / 64; }
                else if (mk == 0 && rep == 0) { Sd.so.init(CH, NIN, G, bx); Sd.A = (const char*)(XN + crow0 * DM); Sd.B = (const char*)(ws + WS_WIN); Sd.C = ZG; lda = DM; ldb = DM; Sd.ldc = NIN; Sd.nt = DM / 64; }
                else if (mk == 0) { Sd.so.init(5120, DM, G, bx); Sd.A = (const char*)MEMN; Sd.B = (const char*)(ws + WS_WKV); Sd.C = KV; lda = DM; ldb = DM; Sd.ldc = DM; Sd.nt = DM / 64; }
                else { Sd.so.init(CH, DM, G, bx); Sd.A = (const char*)ZG; Sd.B = (const char*)(ws + WS_WO); Sd.C = YT; lda = NGT; ldb = DM; Sd.ldc = DM; Sd.nt = DM / 64; }
                Sd.a_tile = (size_t)256 * lda * 2; Sd.b_tile = (size_t)256 * ldb * 2; Sd.ccols = 256;
                pg8::EpiStore<0> E{Sd.ldc, nullptr};
                pg8::gemm_phase<pg8::EpiStore<0>, SchedStd>(lds, tid, lda, ldb, Sd, E);
            }
        }
#endif
#ifndef DIS_R3
        if (ph == 3) {
            for (int row = gw; row < TT; row += ngw) {
                const float* xr = (row < TP) ? args.in[0] + (size_t)row * DM : args.in[1] + (size_t)(row - TP) * DM;
                row_op(XN + (size_t)row * DM, xr, out + (size_t)row * DM, XN + (size_t)row * DM, args.in[8], args.in[9], 0.5f, lane);
            }
            for (int row = gw; row < 5120; row += ngw) {
                const float* xr = (row < 4096) ? args.in[2] + (size_t)row * DM : args.in[3] + (size_t)(row - 4096) * DM;
                row_op(nullptr, xr, nullptr, MEMN + (size_t)row * DM, nullptr, args.in[10], 0.f, lane);
            }
            const int gt = bx * 512 + tid, ngt = G * 512;
            for (int which = 0; which < 2; ++which) {
                const int SS = which ? 4096 : 2048; bf16_t* DS = which ? DS4 : DS2; const float scl = which ? 0.015625f : 0.022097086912079608f; const float inv = 2.0f / (float)SS;
                const int per_row = (2 * SS) / 8, total = SS * per_row;
                for (int idx = gt; idx < total; idx += ngt) { const int j = idx / per_row, k8 = (idx - j * per_row) * 8; float vv[8];
#pragma unroll
                    for (int e = 0; e < 8; ++e) { const int k = k8 + e; const int kk = k & (SS - 1); const int mm = (j * kk) & (SS - 1); const float x = (float)mm * inv;
                        vv[e] = (k >= SS) ? -sinpif(x) * scl : cospif(x) * scl; }
                    u32x4 w; w.x = cvt_pk_bf16(vv[0], vv[1]); w.y = cvt_pk_bf16(vv[2], vv[3]); w.z = cvt_pk_bf16(vv[4], vv[5]); w.w = cvt_pk_bf16(vv[6], vv[7]);
                    *(u32x4*)(DS + (size_t)j * (2 * SS) + k8) = w; }
            }
            for (int idx = gt; idx < 512 * 256 / 8; idx += ngt) { const int mrow = idx / 32, c8 = (idx - mrow * 32) * 8; float vv[8];
#pragma unroll
                for (int e = 0; e < 8; ++e) { const int cc = c8 + e; const int mm = ((mrow & 255) * cc) & 255; const float x = (float)mm * (2.0f / 256.0f);
                    vv[e] = (mrow >= 256) ? sinpif(x) * 0.0625f : cospif(x) * 0.0625f; }
                u32x4 w; w.x = cvt_pk_bf16(vv[0], vv[1]); w.y = cvt_pk_bf16(vv[2], vv[3]); w.z = cvt_pk_bf16(vv[4], vv[5]); w.w = cvt_pk_bf16(vv[6], vv[7]);
                *(u32x4*)(D256 + (size_t)mrow * 256 + c8) = w; }
        }
#endif
#ifndef DIS_M1
        if (mk == 1) {
#ifndef DIS_F1
            { SchedF1 Sf{(const char*)D256, (const char*)ZG, YT, S, nseq * 4 * 2 * (S >> 8), G, bx};
              pg8::EpiStore<0> E{2 * S, nullptr};
              pg8::gemm_phase<pg8::EpiStore<0>, SchedF1>(lds, tid, 256, NIN, Sf, E); }
#endif
            LAS float* biasL = (LAS float*)lds;
#ifndef DIS_BIAS
            for (int idx = tid; idx < 12 * 129; idx += 512) { const int h12 = idx / 129, dd = idx - h12 * 129 - 64; const int g = h12 >> 2;
                biasL[h12 * 132 + dd + 64] = args.in[4][t5_bucket(dd * (1 << (2 * g))) * 12 + h12] * LOG2E; }
#endif
            __syncthreads();
#ifndef DIS_DIL
            for (int u = gw; u < 12 * 512; u += ngw) dil_attn_unit(ZG, LSE, biasL, S, u, lane);
#endif
#ifndef DIS_MEM
            for (int u = gw; u < 4 * 512; u += ngw) { const int w = u & 511; const int bglob = (chunk == 2 ? 16 : chunk * 8) + (w * 32) / S;
                mem_attn_unit(ZG, KV + (size_t)bglob * 256 * 2048, AFM, u, lane); }
#endif
            __syncthreads();
        }
#endif
#ifndef DIS_M2
        if (mk == 2) {
            { SchedF2 Sf{(const char*)(chunk == 2 ? DS4 : DS2), (const char*)YT, AFM, S, nseq * (S >> 8) * 4, G, bx};
              pg8::EpiStore<0> E{NAFM, nullptr};
              pg8::gemm_phase<pg8::EpiStore<0>, SchedF2>(lds, tid, 2 * S, 2 * S, Sf, E); }
            for (int t = gw; t < CH; t += ngw) { const int j = lane >> 4, e0 = (lane & 15) * 8;
                const float l0 = LSE[(size_t)t * 12 + j], l1 = LSE[(size_t)t * 12 + 4 + j], l2 = LSE[(size_t)t * 12 + 8 + j];
                const float mxl = fmaxf(l0, fmaxf(l1, l2)); float w0 = __builtin_amdgcn_exp2f(l0 - mxl), w1 = __builtin_amdgcn_exp2f(l1 - mxl), w2 = __builtin_amdgcn_exp2f(l2 - mxl);
                const float iw = 1.0f / (w0 + w1 + w2); w0 *= iw; w1 *= iw; w2 *= iw;
                const bf16_t* zr = ZG + (size_t)t * NIN + j * 128 + e0;
                const u32x4 a = *(const u32x4*)zr, b = *(const u32x4*)(zr + 512), c = *(const u32x4*)(zr + 1024);
                u32x4 o;
                o.x = cvt_pk_bf16(w0 * bf_lo(a.x) + w1 * bf_lo(b.x) + w2 * bf_lo(c.x), w0 * bf_hi(a.x) + w1 * bf_hi(b.x) + w2 * bf_hi(c.x));
                o.y = cvt_pk_bf16(w0 * bf_lo(a.y) + w1 * bf_lo(b.y) + w2 * bf_lo(c.y), w0 * bf_hi(a.y) + w1 * bf_hi(b.y) + w2 * bf_hi(c.y));
                o.z = cvt_pk_bf16(w0 * bf_lo(a.z) + w1 * bf_lo(b.z) + w2 * bf_lo(c.z), w0 * bf_hi(a.z) + w1 * bf_hi(b.z) + w2 * bf_hi(c.z));
                o.w = cvt_pk_bf16(w0 * bf_lo(a.w) + w1 * bf_lo(b.w) + w2 * bf_lo(c.w), w0 * bf_hi(a.w) + w1 * bf_hi(b.w) + w2 * bf_hi(c.w));
                *(u32x4*)(AFM + (size_t)t * NAFM + j * 128 + e0) = o; }
        }
#endif
#ifndef DIS_M3
        if (mk == 3) {
            SchedStd Sd; Sd.so.init(CH, NGT, G, bx); Sd.A = (const char*)(XN + crow0 * DM); Sd.B = (const char*)(ws + WS_WG); Sd.C = ZG;
            Sd.a_tile = (size_t)256 * DM * 2; Sd.b_tile = (size_t)256 * DM * 2; Sd.ldc = NGT; Sd.ccols = 256; Sd.nt = DM / 64;
            pg8::EpiStore<0> E{NGT, nullptr};
            pg8::gemm_phase<pg8::EpiStore<0>, SchedStd>(lds, tid, DM, DM, Sd, E);
        }
#endif
#ifndef DIS_M4
        if (mk == 4) {
            SchedP Sp; Sp.so.init(CH, DM, G, bx); Sp.AFM = (const char*)AFM; Sp.WP = (const char*)(ws + WS_WP); Sp.Gc = ZG;
            pg8::EpiGateRMW E{NGT, args.in[14]};
            pg8::gemm_phase<pg8::EpiGateRMW, SchedP>(lds, tid, NAFM, NAFM, Sp, E);
        }
#endif
#ifndef DIS_R6
        if (mk == 6 || ph == 27) {
            const int r0 = (ph == 27) ? 0 : (int)crow0, nr = (ph == 27) ? TT : CH;
            for (int row = gw; row < nr; row += ngw) { const size_t gr = (size_t)(r0 + row);
                const bf16_t* yr = (ph == 27) ? XN + gr * DM : YT + (size_t)row * DM;
                row_op(yr, out + gr * DM, out + gr * DM, (ph == 27) ? nullptr : XN + gr * DM, (ph == 27 ? args.in[23] : args.in[19]), args.in[20], ph == 27 ? 0.5f : 1.0f, lane); }
        }
#endif

#if MK_COOP
        if (pi + 1 < args.ph_hi) { if (pi == args.ph_lo) grid.sync(); else xcd_barrier(xbar); }
#endif
    }
}

extern "C" void kernel_launch(void* const* d_in, const int* in_sizes, int n_in, void* d_out, int out_size, void* d_ws, size_t ws_size, hipStream_t stream) {
    static int grid = 0;
    if (grid == 0) {
        if (n_in != 24 || out_size != TT * DM || ws_size < WS_END) { fprintf(stderr, "kernel_launch: unexpected shapes (n_in %d out %d ws %zu)\n", n_in, out_size, ws_size); grid = -1; return; }
        int dev = 0, cus = 0, per_cu = 0;
        hipGetDevice(&dev); hipDeviceGetAttribute(&cus, hipDeviceAttributeMultiprocessorCount, dev);
        if (hipFuncSetAttribute((const void*)mk_fwd, hipFuncAttributeMaxDynamicSharedMemorySize, LDS_BYTES) != hipSuccess) { fprintf(stderr, "kernel_launch: hipFuncSetAttribute failed\n"); grid = -1; return; }
        if (hipOccupancyMaxActiveBlocksPerMultiprocessor(&per_cu, (const void*)mk_fwd, 512, LDS_BYTES) != hipSuccess || per_cu < 1) { fprintf(stderr, "kernel_launch: occupancy query says %d\n", per_cu); per_cu = 1; }
        (void)hipGetLastError();
        grid = cus * 1;
    }
    if (grid < 0) return;
    Args a{};
    for (int i = 0; i < 24; ++i) a.in[i] = (const float*)d_in[i];
    a.out = (float*)d_out; a.ws = (unsigned char*)d_ws;
#if MK_COOP
    (void)hipMemsetAsync(d_ws, 0, 16384, stream);
    a.ph_lo = 0; a.ph_hi = N_PHASES + (PROBE_DUP < 1000 ? 1 : 0); a.coop = 1;
    void* kargs[] = {&a};
    hipError_t e = hipLaunchCooperativeKernel((const void*)mk_fwd, dim3(grid), dim3(512), kargs, LDS_BYTES, stream);
    if (e != hipSuccess) fprintf(stderr, "cooperative launch failed: %s (grid %d)\n", hipGetErrorString(e), grid);
#else
    for (int ph = 0; ph < N_PHASES; ++ph) {
        a.ph_lo = ph; a.ph_hi = ph + 1; a.coop = 0;
        hipLaunchKernelGGL(mk_fwd, dim3(grid), dim3(512), LDS_BYTES, stream, a);
    }
#endif
}
```

```cpp
#include <hip/hip_runtime.h>
#include <hip/hip_cooperative_groups.h>
#include <cstdio>
#include <cstdint>
namespace cg = cooperative_groups;

#ifndef MK_COOP
#define MK_COOP 1
#endif

#define LAS __attribute__((address_space(3)))
typedef unsigned short bf16_t;
typedef short bf16x8 __attribute__((ext_vector_type(8)));
typedef float f32x4 __attribute__((ext_vector_type(4)));
typedef float f32x16 __attribute__((ext_vector_type(16)));
typedef unsigned u32x4 __attribute__((ext_vector_type(4)));
typedef unsigned u32x2 __attribute__((ext_vector_type(2)));

constexpr int TT = 49152, DM = 2048, DFF = 5632, NIN = 6656, NGT = 6144, CH = 16384, NAFM = 2560;
constexpr int TP = 32768;
constexpr float RMS_EPS = 1e-6f;
constexpr float LOG2E = 1.4426950408889634f;
constexpr size_t MiB = 1u << 20;
constexpr size_t WS_W1U = 1 * MiB;
constexpr size_t WS_W1D = WS_W1U + 44 * MiB;
constexpr size_t WS_YT = WS_W1D + 22 * MiB;
constexpr size_t WS_WIN = WS_YT + 66 * MiB;
constexpr size_t WS_WG = WS_WIN + 26 * MiB;
constexpr size_t WS_WKV = WS_WG + 24 * MiB;
constexpr size_t WS_WP = WS_WKV + 8 * MiB;
constexpr size_t WS_WO = WS_WP + 10 * MiB;
constexpr size_t WS_XN = WS_WO + 8 * MiB;
constexpr size_t WS_H = WS_XN + 192 * MiB;
constexpr size_t WS_ZG = WS_H;
constexpr size_t WS_GG = WS_ZG + 208 * MiB;
constexpr size_t WS_AFM = WS_GG + 192 * MiB;
constexpr size_t WS_LSE = WS_AFM + 80 * MiB;
constexpr size_t WS_MEMN = WS_LSE + 1 * MiB;
constexpr size_t WS_KV = WS_MEMN + 20 * MiB;
constexpr size_t WS_HEND = WS_H + 528 * MiB;
static_assert(WS_KV + 20 * MiB <= WS_HEND, "overlay map");
constexpr size_t WS_DS2 = WS_HEND;
constexpr size_t WS_DS4 = WS_DS2 + 16 * MiB;
constexpr size_t WS_D256 = WS_DS4 + 64 * MiB;
constexpr size_t WS_END = WS_D256 + 1 * MiB;
static_assert(WS_END <= 1024 * MiB, "workspace");

constexpr int LDS_BYTES = 140288;

__device__ __forceinline__ unsigned cvt_pk_bf16(float lo, float hi) { unsigned r; asm volatile("v_cvt_pk_bf16_f32 %0, %1, %2" : "=v"(r) : "v"(lo), "v"(hi)); return r; }
__device__ __forceinline__ float bf_lo(unsigned u) { return __uint_as_float(u << 16); }
__device__ __forceinline__ float bf_hi(unsigned u) { return __uint_as_float(u & 0xffff0000u); }
__device__ __forceinline__ float wave_sum(float v) {
#pragma unroll
    for (int o = 1; o < 64; o <<= 1) v += __shfl_xor(v, o);
    return v;
}
__device__ __forceinline__ float sigmoidf_(float x) { return __builtin_amdgcn_rcpf(1.0f + __builtin_amdgcn_exp2f(-x * LOG2E)); }

namespace pg8 {
constexpr int BM = 256, BK = 64, HALF = 128, HTB = HALF * BK * 2, STAGE_BYTES = 8 * HTB, NXCD = 8, WGM = 4;
__host__ __device__ __forceinline__ int lds_byte(int r, int c) { const int st = (r >> 4) * 2 + (c >> 5), rr = r & 15, cc = c & 31, ob = rr * 64 + cc * 2; return st * 1024 + (ob ^ (((ob >> 9) & 1) << 5)); }
__host__ __device__ __forceinline__ void stage_rc(int b, int& R, int& C) { const int st = b / 1024, sb = b % 1024, swz = sb ^ (((sb >> 9) & 1) << 5); R = (st >> 1) * 16 + swz / 64; C = (st & 1) * 32 + (swz % 64) / 2; }
__host__ __device__ __forceinline__ int perm32(int rho) { const int n = rho >> 4, i = rho & 15; return 8 * (i >> 2) + 4 * n + (i & 3); }

struct Unit { const char* A; const char* B; bf16_t* C; const bf16_t* C2; int nt; int aux; };
struct PN { int pm, pn; };
struct StaticOrder {
    int nM, nN, nwg, G, c;
    __device__ void init(int M, int N, int G_, int c_) { nM = M / BM; nN = N / BM; nwg = nM * nN; G = G_; c = c_; }
    __device__ bool next(int i, PN& u) const {
        const long L = (long)i * G + c; if (L >= nwg) return false;
        int wgid = (int)L; { const int q = nwg / NXCD, r = nwg % NXCD, xcd = wgid % NXCD, off = wgid / NXCD; wgid = (xcd < r ? xcd * (q + 1) : r * (q + 1) + (xcd - r) * q) + off; }
        const int nig = WGM * nN, gid = wgid / nig, fm = gid * WGM, gsz = (nM - fm) < WGM ? (nM - fm) : WGM;
        u.pm = fm + ((wgid % nig) % gsz); u.pn = (wgid % nig) / gsz; return true;
    }
};

template <int ACT> struct EpiStore {
    int ldc; const float* bias;
    __device__ __forceinline__ void operator()(const f32x4 (&acc)[2][2][4][2], const Unit& u, int wr, int wc, int fr, int fq) const {
        bf16_t* base = u.C + (size_t)(wr * 64 + fr) * ldc + wc * 32 + 8 * fq;
        f32x4 bv[2][2];
        if (ACT == 1) {
#pragma unroll
            for (int bj = 0; bj < 2; ++bj)
#pragma unroll
                for (int n = 0; n < 2; ++n) bv[bj][n] = *(const f32x4*)(bias + u.aux + bj * HALF + wc * 32 + 8 * fq + 4 * n);
        }
#pragma unroll
        for (int ai = 0; ai < 2; ++ai)
#pragma unroll
            for (int m = 0; m < 4; ++m) { bf16_t* rowp = base + (size_t)(ai * HALF + m * 16) * ldc;
#pragma unroll
                for (int bj = 0; bj < 2; ++bj) { f32x4 v0 = acc[ai][bj][m][0], v1 = acc[ai][bj][m][1];
                    if (ACT == 1) { v0 = v0 + bv[bj][0]; v1 = v1 + bv[bj][1];
#pragma unroll
                        for (int e = 0; e < 4; ++e) { v0[e] = sigmoidf_(v0[e]); v1[e] = sigmoidf_(v1[e]); } }
                    u32x4 w; w.x = cvt_pk_bf16(v0[0], v0[1]); w.y = cvt_pk_bf16(v0[2], v0[3]); w.z = cvt_pk_bf16(v1[0], v1[1]); w.w = cvt_pk_bf16(v1[2], v1[3]);
                    *(u32x4*)(rowp + bj * HALF) = w; } }
    }
};
struct EpiSwiGLU {
    int ldc;
    __device__ __forceinline__ void operator()(const f32x4 (&acc)[2][2][4][2], const Unit& u, int wr, int wc, int fr, int fq) const {
        bf16_t* base = u.C + (size_t)(wr * 64 + fr) * ldc + wc * 32 + 8 * fq;
#pragma unroll
        for (int ai = 0; ai < 2; ++ai)
#pragma unroll
            for (int m = 0; m < 4; ++m) { bf16_t* rowp = base + (size_t)(ai * HALF + m * 16) * ldc;
                f32x4 v0, v1;
#pragma unroll
                for (int e = 0; e < 4; ++e) { const float a0 = acc[ai][0][m][0][e], a1 = acc[ai][0][m][1][e];
                    v0[e] = a0 * sigmoidf_(a0) * acc[ai][1][m][0][e]; v1[e] = a1 * sigmoidf_(a1) * acc[ai][1][m][1][e]; }
                u32x4 w; w.x = cvt_pk_bf16(v0[0], v0[1]); w.y = cvt_pk_bf16(v0[2], v0[3]); w.z = cvt_pk_bf16(v1[0], v1[1]); w.w = cvt_pk_bf16(v1[2], v1[3]);
                *(u32x4*)rowp = w; }
    }
};
struct EpiGateRMW {
    int ldc; const float* bias;
    __device__ __forceinline__ void operator()(const f32x4 (&acc)[2][2][4][2], const Unit& u, int wr, int wc, int fr, int fq) const {
        const size_t off0 = (size_t)(wr * 64 + fr) * ldc + wc * 32 + 8 * fq;
        f32x4 bv[2][2];
#pragma unroll
        for (int bj = 0; bj < 2; ++bj)
#pragma unroll
            for (int n = 0; n < 2; ++n) bv[bj][n] = *(const f32x4*)(bias + (u.aux >> 2) + bj * HALF + wc * 32 + 8 * fq + 4 * n);
#pragma unroll
        for (int ai = 0; ai < 2; ++ai)
#pragma unroll
            for (int m = 0; m < 4; ++m) { const size_t ro = off0 + (size_t)(ai * HALF + m * 16) * ldc;
#pragma unroll
                for (int bj = 0; bj < 2; ++bj) {
                    const u32x4 g = *(const u32x4*)(u.C2 + ro + bj * HALF);
                    u32x4 o = (u32x4){0u, 0u, 0u, 0u}; if (u.aux & 3) o = *(const u32x4*)(u.C + ro + bj * HALF);
                    const f32x4 a0 = acc[ai][bj][m][0], a1 = acc[ai][bj][m][1];
                    const f32x4 b0 = bv[bj][0], b1 = bv[bj][1];
                    u32x4 w;
                    w.x = cvt_pk_bf16(bf_lo(o.x) + sigmoidf_(bf_lo(g.x) + b0[0]) * a0[0], bf_hi(o.x) + sigmoidf_(bf_hi(g.x) + b0[1]) * a0[1]);
                    w.y = cvt_pk_bf16(bf_lo(o.y) + sigmoidf_(bf_lo(g.y) + b0[2]) * a0[2], bf_hi(o.y) + sigmoidf_(bf_hi(g.y) + b0[3]) * a0[3]);
                    w.z = cvt_pk_bf16(bf_lo(o.z) + sigmoidf_(bf_lo(g.z) + b1[0]) * a1[0], bf_hi(o.z) + sigmoidf_(bf_hi(g.z) + b1[1]) * a1[1]);
                    w.w = cvt_pk_bf16(bf_lo(o.w) + sigmoidf_(bf_lo(g.w) + b1[2]) * a1[2], bf_hi(o.w) + sigmoidf_(bf_hi(g.w) + b1[3]) * a1[3]);
                    *(u32x4*)(u.C + ro + bj * HALF) = w; } }
    }
};

template <class Epi, class Sched>
__device__ __forceinline__ void gemm_phase(LAS unsigned char* lds, const int tid, const int lda, const int ldb, const Sched& S, const Epi& E) {
    const int wid = __builtin_amdgcn_readfirstlane(tid >> 6), lane = tid & 63, wr = wid >> 2, wc = wid & 3, fr = lane & 15, fq = lane >> 4;
    unsigned voffA[2], voffB[2];
#pragma unroll
    for (int i = 0; i < 2; ++i) { int R, C; stage_rc(tid * 16 + i * 8192, R, C); const int Rb = (R & ~31) + perm32(R & 31);
        voffA[i] = (unsigned)(R * lda + C) * 2u; voffB[i] = (unsigned)(Rb * ldb + C) * 2u; }
    const size_t kstep = (size_t)(BK * 2);
    const size_t hstepA = (size_t)HALF * lda * 2, hstepB = (size_t)HALF * ldb * 2;
    const unsigned ldsw = (unsigned)wid * 1024u;
    const int aoff = lds_byte(wr * 64 + fr, fq * 8), boff = lds_byte(wc * 32 + fr, fq * 8);
#define PG8_SA(b, h) (((b) * 2 + (h)) * HTB)
#define PG8_SB(b, h) ((4 + (b) * 2 + (h)) * HTB)
#define PG8_STAGE(bufoff, gbase, voff) do { _Pragma("unroll") for (int _i = 0; _i < 2; ++_i) \
        __builtin_amdgcn_global_load_lds((const unsigned*)((const char*)(gbase) + (voff)[_i]), (LAS unsigned*)(lds + (bufoff) + ldsw + _i * 8192), 16, 0, 0); } while (0)
#define PG8_LDA(dst, b, h) do { _Pragma("unroll") for (int m = 0; m < 4; ++m) _Pragma("unroll") for (int k = 0; k < 2; ++k) dst[m][k] = *(const LAS bf16x8*)(lds + PG8_SA(b, h) + aoff + m * 2048 + k * 1024); } while (0)
#define PG8_LDB(dst, b, h) do { _Pragma("unroll") for (int n = 0; n < 2; ++n) _Pragma("unroll") for (int k = 0; k < 2; ++k) dst[n][k] = *(const LAS bf16x8*)(lds + PG8_SB(b, h) + boff + n * 2048 + k * 1024); } while (0)
#define PG8_MMA(ai, bj, At, Bt) do { __builtin_amdgcn_s_setprio(1); _Pragma("unroll") for (int m = 0; m < 4; ++m) _Pragma("unroll") for (int n = 0; n < 2; ++n) _Pragma("unroll") for (int k = 0; k < 2; ++k) \
        acc[ai][bj][m][n] = __builtin_amdgcn_mfma_f32_16x16x32_bf16(Bt[n][k], At[m][k], acc[ai][bj][m][n], 0, 0, 0); __builtin_amdgcn_s_setprio(0); } while (0)
#define PG8_WAIT_V(n) asm volatile("s_waitcnt vmcnt(" #n ")" ::: "memory")
#define PG8_WAIT_L(n) asm volatile("s_waitcnt lgkmcnt(" #n ")" ::: "memory")
#define PG8_BAR __builtin_amdgcn_s_barrier()
#define PG8_SCHED __builtin_amdgcn_sched_barrier(0)
    Unit cur, nxt; int ui = 0;
    if (!S.next(0, cur)) return;
    f32x4 acc[2][2][4][2];
#pragma unroll
    for (int a = 0; a < 2; ++a)
#pragma unroll
        for (int b = 0; b < 2; ++b)
#pragma unroll
            for (int m = 0; m < 4; ++m)
#pragma unroll
                for (int n = 0; n < 2; ++n) acc[a][b][m][n] = (f32x4){0.f, 0.f, 0.f, 0.f};
    bf16x8 At[4][2], B0[2][2], B1[2][2];
    const char* cA = cur.A; const char* cB = cur.B;
    PG8_STAGE(PG8_SB(0, 0), cB, voffB); PG8_STAGE(PG8_SB(0, 1), cB + hstepB, voffB); PG8_STAGE(PG8_SA(0, 0), cA, voffA); PG8_STAGE(PG8_SA(0, 1), cA + hstepA, voffA);
    if (wr == 1) PG8_BAR;
    PG8_WAIT_V(2); PG8_BAR;
    PG8_STAGE(PG8_SB(1, 0), cB + kstep, voffB); PG8_STAGE(PG8_SA(1, 0), cA + kstep, voffA); PG8_STAGE(PG8_SB(1, 1), cB + hstepB + kstep, voffB);
    PG8_WAIT_V(6); PG8_BAR;
    for (;;) {
        const bool has_next = S.next(ui + 1, nxt);
        const char* nA = has_next ? nxt.A : cA; const char* nB = has_next ? nxt.B : cB;
        int nt = cur.nt; asm volatile("" : "+s"(nt));
        for (int t = 0; t < nt; t += 2) {
            const bool last = (t == nt - 2);
            const char* a1 = cA + (size_t)(t + 1) * kstep;
            const char* a2 = last ? nA : cA + (size_t)(t + 2) * kstep; const char* b2 = last ? nB : cB + (size_t)(t + 2) * kstep;
            const char* a3 = a2 + kstep; const char* b3 = b2 + kstep;
            PG8_LDB(B0, 0, 0); PG8_LDB(B1, 0, 1); PG8_SCHED; PG8_LDA(At, 0, 0); PG8_STAGE(PG8_SA(1, 1), a1 + hstepA, voffA);
            PG8_WAIT_V(8); PG8_WAIT_L(0); PG8_BAR; PG8_MMA(0, 0, At, B0); PG8_MMA(0, 1, At, B1); PG8_BAR; PG8_SCHED;
            PG8_LDA(At, 0, 1); PG8_STAGE(PG8_SB(0, 0), b2, voffB); PG8_STAGE(PG8_SB(0, 1), b2 + hstepB, voffB); PG8_STAGE(PG8_SA(0, 0), a2, voffA);
            PG8_WAIT_V(8); PG8_WAIT_L(0); PG8_BAR; PG8_MMA(1, 0, At, B0); PG8_MMA(1, 1, At, B1); PG8_BAR; PG8_SCHED;
            PG8_LDB(B0, 1, 0); PG8_LDB(B1, 1, 1); PG8_SCHED; PG8_LDA(At, 1, 0); PG8_STAGE(PG8_SA(0, 1), a2 + hstepA, voffA);
            PG8_WAIT_V(8); PG8_WAIT_L(0); PG8_BAR; PG8_MMA(0, 0, At, B0); PG8_MMA(0, 1, At, B1); PG8_BAR; PG8_SCHED;
            PG8_LDA(At, 1, 1); PG8_STAGE(PG8_SB(1, 0), b3, voffB); PG8_STAGE(PG8_SB(1, 1), b3 + hstepB, voffB); PG8_STAGE(PG8_SA(1, 0), a3, voffA);
            PG8_WAIT_V(8); PG8_WAIT_L(0); PG8_BAR; PG8_MMA(1, 0, At, B0); PG8_MMA(1, 1, At, B1); PG8_BAR; PG8_SCHED;
        }
        if (wr == 0) PG8_BAR;
        E(acc, cur, wr, wc, fr, fq);
        if (!has_next) break;
#pragma unroll
        for (int a = 0; a < 2; ++a)
#pragma unroll
            for (int b = 0; b < 2; ++b)
#pragma unroll
                for (int m = 0; m < 4; ++m)
#pragma unroll
                    for (int n = 0; n < 2; ++n) acc[a][b][m][n] = (f32x4){0.f, 0.f, 0.f, 0.f};
        cur = nxt; cA = nA; cB = nB; ++ui;
        if (wr == 1) PG8_BAR;
    }
    PG8_WAIT_V(0);
    PG8_BAR;
#undef PG8_SA
#undef PG8_SB
#undef PG8_STAGE
#undef PG8_LDA
#undef PG8_LDB
#undef PG8_MMA
#undef PG8_WAIT_V
#undef PG8_WAIT_L
#undef PG8_BAR
#undef PG8_SCHED
}
}

struct SchedStd {
    pg8::StaticOrder so; const char* A; const char* B; bf16_t* C; size_t a_tile, b_tile; int ldc, ccols, nt;
    __device__ __forceinline__ bool next(int i, pg8::Unit& u) const {
        pg8::PN p; if (!so.next(i, p)) return false;
        u.A = A + (size_t)p.pm * a_tile; u.B = B + (size_t)p.pn * b_tile; u.C = C + (size_t)p.pm * 256 * ldc + (size_t)p.pn * ccols; u.C2 = nullptr; u.nt = nt; u.aux = p.pn * 256; return true; }
};
struct SchedF1 {
    const char* D; const char* Z; bf16_t* Yt; int S, nunits, G, c;
    __device__ __forceinline__ bool next(int i, pg8::Unit& u) const {
        const int L = i * G + c; if (L >= nunits) return false;
        const int lg = (S == 4096) ? 4 : 3; const int pn = L & ((1 << lg) - 1); int t = L >> lg; const int pm = t & 1; t >>= 1; const int g = t & 3; const int b = t >> 2;
        u.A = D + (size_t)pm * 256 * 256 * 2; u.B = Z + ((size_t)(b * S + pn * 256) * NIN + 4608 + g * 256) * 2;
        u.C = Yt + (size_t)(b * 1024 + g * 256) * (2 * S) + (size_t)pm * S + pn * 256; u.C2 = nullptr; u.nt = 4; u.aux = 0; return true; }
};
struct SchedF2 {
    const char* DS; const char* Yt; bf16_t* AFM; int S, nunits, G, c;
    __device__ __forceinline__ bool next(int i, pg8::Unit& u) const {
        const int L = i * G + c; if (L >= nunits) return false;
        const int lg = (S == 4096) ? 4 : 3; const int pn = L & 3; const int t = L >> 2; const int pm = t & ((1 << lg) - 1); const int b = t >> lg;
        u.A = DS + (size_t)pm * 256 * (2 * S) * 2; u.B = Yt + (size_t)(b * 1024 + pn * 256) * (2 * S) * 2;
        u.C = AFM + (size_t)(b * S + pm * 256) * NAFM + 512 + pn * 256; u.C2 = nullptr; u.nt = (2 * S) >> 6; u.aux = 0; return true; }
};
struct SchedP {
    pg8::StaticOrder so; const char* AFM; const char* WP; bf16_t* Gc;
    __device__ __forceinline__ bool next(int i, pg8::Unit& u) const {
        const int j = i / 3, b = i - 3 * j; pg8::PN p; if (!so.next(j, p)) return false;
        const int koff = (b == 0) ? 0 : (b == 1 ? 512 : 1536);
        u.A = AFM + ((size_t)p.pm * 256 * NAFM + koff) * 2; u.B = WP + ((size_t)p.pn * 256 * NAFM + koff) * 2;
        u.C = Gc + (size_t)p.pm * 256 * NGT + p.pn * 256; u.C2 = u.C + b * 2048; u.nt = (b == 0) ? 8 : 16; u.aux = b + 4 * (b * 2048 + p.pn * 256); return true; }
};

template <bool XIN_BF16, bool XOUT_BF16>
__device__ __forceinline__ void row_op(const bf16_t* y, const void* xin_, void* xout_, bf16_t* xn, const float* g_post, const float* g_pre, float cres, int lane) {
    float v[32];
    if (XIN_BF16) { const bf16_t* xin = (const bf16_t*)xin_;
#pragma unroll
        for (int j = 0; j < 4; ++j) { const u32x4 w = *(const u32x4*)(xin + j * 512 + lane * 8);
            v[j * 8 + 0] = bf_lo(w.x); v[j * 8 + 1] = bf_hi(w.x); v[j * 8 + 2] = bf_lo(w.y); v[j * 8 + 3] = bf_hi(w.y);
            v[j * 8 + 4] = bf_lo(w.z); v[j * 8 + 5] = bf_hi(w.z); v[j * 8 + 6] = bf_lo(w.w); v[j * 8 + 7] = bf_hi(w.w); }
    } else { const float* xin = (const float*)xin_;
#pragma unroll
    for (int j = 0; j < 4; ++j) { const int e0 = j * 512 + lane * 8; const f32x4 a = *(const f32x4*)(xin + e0), b = *(const f32x4*)(xin + e0 + 4);
#pragma unroll
        for (int e = 0; e < 4; ++e) { v[j * 8 + e] = a[e]; v[j * 8 + 4 + e] = b[e]; } }
    }
    if (y) {
        float yv[32]; float ss = 0.f;
#pragma unroll
        for (int j = 0; j < 4; ++j) { const u32x4 w = *(const u32x4*)(y + j * 512 + lane * 8);
            yv[j * 8 + 0] = bf_lo(w.x); yv[j * 8 + 1] = bf_hi(w.x); yv[j * 8 + 2] = bf_lo(w.y); yv[j * 8 + 3] = bf_hi(w.y);
            yv[j * 8 + 4] = bf_lo(w.z); yv[j * 8 + 5] = bf_hi(w.z); yv[j * 8 + 6] = bf_lo(w.w); yv[j * 8 + 7] = bf_hi(w.w); }
#pragma unroll
        for (int i = 0; i < 32; ++i) ss += yv[i] * yv[i];
        ss = wave_sum(ss);
        const float rs = cres * (1.0f / sqrtf(ss * (1.0f / DM) + RMS_EPS));
#pragma unroll
        for (int j = 0; j < 4; ++j) { const int e0 = j * 512 + lane * 8; const f32x4 a = *(const f32x4*)(g_post + e0), b = *(const f32x4*)(g_post + e0 + 4);
#pragma unroll
            for (int e = 0; e < 4; ++e) { v[j * 8 + e] += yv[j * 8 + e] * rs * a[e]; v[j * 8 + 4 + e] += yv[j * 8 + 4 + e] * rs * b[e]; } }
    }
    if (xout_) {
        if (XOUT_BF16) { bf16_t* xout = (bf16_t*)xout_;
#pragma unroll
            for (int j = 0; j < 4; ++j) { u32x4 w; w.x = cvt_pk_bf16(v[j * 8 + 0], v[j * 8 + 1]); w.y = cvt_pk_bf16(v[j * 8 + 2], v[j * 8 + 3]); w.z = cvt_pk_bf16(v[j * 8 + 4], v[j * 8 + 5]); w.w = cvt_pk_bf16(v[j * 8 + 6], v[j * 8 + 7]);
                *(u32x4*)(xout + j * 512 + lane * 8) = w; }
        } else { float* xout = (float*)xout_;
#pragma unroll
        for (int j = 0; j < 4; ++j) { const int e0 = j * 512 + lane * 8;
            *(f32x4*)(xout + e0) = (f32x4){v[j * 8 + 0], v[j * 8 + 1], v[j * 8 + 2], v[j * 8 + 3]};
            *(f32x4*)(xout + e0 + 4) = (f32x4){v[j * 8 + 4], v[j * 8 + 5], v[j * 8 + 6], v[j * 8 + 7]}; }
        }
    }
    if (xn) {
        float ss = 0.f;
#pragma unroll
        for (int i = 0; i < 32; ++i) ss += v[i] * v[i];
        ss = wave_sum(ss);
        const float rs = 1.0f / sqrtf(ss * (1.0f / DM) + RMS_EPS);
#pragma unroll
        for (int j = 0; j < 4; ++j) { const int e0 = j * 512 + lane * 8; const f32x4 a = *(const f32x4*)(g_pre + e0), b = *(const f32x4*)(g_pre + e0 + 4);
            u32x4 w; w.x = cvt_pk_bf16(v[j * 8 + 0] * rs * a[0], v[j * 8 + 1] * rs * a[1]); w.y = cvt_pk_bf16(v[j * 8 + 2] * rs * a[2], v[j * 8 + 3] * rs * a[3]);
            w.z = cvt_pk_bf16(v[j * 8 + 4] * rs * b[0], v[j * 8 + 5] * rs * b[1]); w.w = cvt_pk_bf16(v[j * 8 + 6] * rs * b[2], v[j * 8 + 7] * rs * b[3]);
            *(u32x4*)(xn + e0) = w; }
    }
}

__device__ __forceinline__ void transpose_item(const float* W, int N, bf16_t* WT, int ldk, int koff, int row_off, int k0, int n0, LAS float* scr, int lane) {
#pragma unroll 16
    for (int i = 0; i < 64; ++i) scr[i * 65 + lane] = W[(size_t)(k0 + i) * N + n0 + lane];
    asm volatile("s_waitcnt lgkmcnt(0)" ::: "memory");
    const int c = lane & 7;
#pragma unroll
    for (int j = 0; j < 8; ++j) { const int n = (lane >> 3) + 8 * j; const LAS float* s = scr + (8 * c) * 65 + n;
        u32x4 o; o.x = cvt_pk_bf16(s[0 * 65], s[1 * 65]); o.y = cvt_pk_bf16(s[2 * 65], s[3 * 65]); o.z = cvt_pk_bf16(s[4 * 65], s[5 * 65]); o.w = cvt_pk_bf16(s[6 * 65], s[7 * 65]);
        *(u32x4*)(WT + (size_t)(row_off + n) * ldk + koff + k0 + 8 * c) = o; }
    asm volatile("s_waitcnt lgkmcnt(0)" ::: "memory");
}
__device__ __forceinline__ void convert_weight(const float* W, int K, int N, bf16_t* WT, int ldk, int koff, bool swiglu_perm, LAS float* scr, int gw, int ngw, int lane) {
    const int nblk = N / 64, nitems = (K / 64) * nblk;
    for (int it = gw; it < nitems; it += ngw) {
        const int kb = it / nblk, nb = it - kb * nblk, n0 = nb * 64;
        int row_off = n0;
        if (swiglu_perm) { const int half = (n0 >= DFF) ? 1 : 0; const int n1 = n0 - half * DFF; row_off = (n1 >> 7) * 256 + half * 128 + (n1 & 127); }
        transpose_item(W, N, WT, ldk, koff, row_off, kb * 64, n0, scr, lane);
    }
}

__device__ __forceinline__ int crow(int r, int hi) { return (r & 3) + 8 * (r >> 2) + 4 * hi; }
__device__ __forceinline__ bf16x8 pack8(const f32x16& s, int b) {
    u32x4 w; w.x = cvt_pk_bf16(s[b + 0], s[b + 1]); w.y = cvt_pk_bf16(s[b + 2], s[b + 3]); w.z = cvt_pk_bf16(s[b + 4], s[b + 5]); w.w = cvt_pk_bf16(s[b + 6], s[b + 7]);
    return __builtin_bit_cast(bf16x8, w);
}
__device__ __forceinline__ void dil_attn_unit(bf16_t* z, float* lse, const LAS float* biasL, int S, int unit, int lane) {
    const int h12 = unit >> 9, w = unit & 511;
    const int g = h12 >> 2, sh = 2 * g, L = S >> sh;
    const int spb = S >> 5; const int b = w / spb, v = w - b * spb; const int nlb = L >> 5; const int r = v / nlb, lb = v - r * nlb; const int l0 = lb * 32;
    const int q = lane & 31, hi = lane >> 5; const int lq = l0 + q;
    const size_t seqbase = (size_t)b * S;
    bf16_t* qrow = z + (seqbase + ((size_t)lq << sh) + r) * NIN + h12 * 128;
    bf16x8 qf[8];
#pragma unroll
    for (int ks = 0; ks < 8; ++ks) qf[ks] = *(const bf16x8*)(qrow + ks * 16 + hi * 8);
    f32x16 o[4];
#pragma unroll
    for (int dt = 0; dt < 4; ++dt)
#pragma unroll
        for (int i = 0; i < 16; ++i) o[dt][i] = 0.f;
    float m = -1e30f, lsum = 0.f;
    const float sc = 0.08838834764831845f * LOG2E;
    const LAS float* bl = biasL + h12 * 132 + 64;
    for (int kt = 0; kt < 5; ++kt) {
        const int kl0 = l0 - 64 + kt * 32;
        if (kl0 + 31 < 0 || kl0 >= L) continue;
        int kl = kl0 + q; kl = kl < 0 ? 0 : (kl > L - 1 ? L - 1 : kl);
        const bf16_t* kp = z + (seqbase + ((size_t)kl << sh) + r) * NIN + 1536 + h12 * 128 + hi * 8;
        f32x16 s;
#pragma unroll
        for (int i = 0; i < 16; ++i) s[i] = 0.f;
#pragma unroll
        for (int ks = 0; ks < 8; ++ks) { const bf16x8 kf = *(const bf16x8*)(kp + ks * 16); s = __builtin_amdgcn_mfma_f32_32x32x16_bf16(kf, qf[ks], s, 0, 0, 0); }
        float mx = -1e30f;
#pragma unroll
        for (int i = 0; i < 16; ++i) { const int lk = kl0 + crow(i, hi); const int dl = lk - lq; const bool valid = (dl >= -64) && (dl <= 64) && (lk >= 0) && (lk < L);
            const int di = dl < -64 ? -64 : (dl > 64 ? 64 : dl);
            const float vv = valid ? (s[i] * sc + bl[di]) : -1e30f; s[i] = vv; mx = fmaxf(mx, vv); }
        mx = fmaxf(mx, __shfl_xor(mx, 32));
        const float mn = fmaxf(m, mx); const float f = __builtin_amdgcn_exp2f(m - mn); m = mn;
        float ps = 0.f;
#pragma unroll
        for (int i = 0; i < 16; ++i) { const float p = __builtin_amdgcn_exp2f(s[i] - mn); s[i] = p; ps += p; }
        lsum = lsum * f + ps;
#pragma unroll
        for (int dt = 0; dt < 4; ++dt)
#pragma unroll
            for (int i = 0; i < 16; ++i) o[dt][i] *= f;
        const bf16x8 pa0 = pack8(s, 0), pa1 = pack8(s, 8);
#pragma unroll
        for (int s_ = 0; s_ < 2; ++s_) {
            u32x2 vv[8];
#pragma unroll
            for (int i = 0; i < 8; ++i) { int lk = kl0 + crow(8 * s_ + i, hi); lk = lk < 0 ? 0 : (lk > L - 1 ? L - 1 : lk);
                vv[i] = *(const u32x2*)(z + (seqbase + ((size_t)lk << sh) + r) * NIN + 3072 + h12 * 128 + 4 * q); }
#pragma unroll
            for (int dt = 0; dt < 4; ++dt) { u32x4 w;
                const unsigned sel = (dt & 1) ? 0x07060302u : 0x05040100u;
                if (dt < 2) { w.x = __builtin_amdgcn_perm(vv[1].x, vv[0].x, sel); w.y = __builtin_amdgcn_perm(vv[3].x, vv[2].x, sel); w.z = __builtin_amdgcn_perm(vv[5].x, vv[4].x, sel); w.w = __builtin_amdgcn_perm(vv[7].x, vv[6].x, sel); }
                else        { w.x = __builtin_amdgcn_perm(vv[1].y, vv[0].y, sel); w.y = __builtin_amdgcn_perm(vv[3].y, vv[2].y, sel); w.z = __builtin_amdgcn_perm(vv[5].y, vv[4].y, sel); w.w = __builtin_amdgcn_perm(vv[7].y, vv[6].y, sel); }
                o[dt] = __builtin_amdgcn_mfma_f32_32x32x16_bf16(__builtin_bit_cast(bf16x8, w), s_ ? pa1 : pa0, o[dt], 0, 0, 0); }
        }
    }
    lsum += __shfl_xor(lsum, 32);
    const float inv = 1.0f / lsum;
#pragma unroll
    for (int rg = 0; rg < 4; ++rg) {
        u32x4 w0, w1;
        w0.x = cvt_pk_bf16(o[0][4 * rg + 0] * inv, o[1][4 * rg + 0] * inv); w0.y = cvt_pk_bf16(o[2][4 * rg + 0] * inv, o[3][4 * rg + 0] * inv);
        w0.z = cvt_pk_bf16(o[0][4 * rg + 1] * inv, o[1][4 * rg + 1] * inv); w0.w = cvt_pk_bf16(o[2][4 * rg + 1] * inv, o[3][4 * rg + 1] * inv);
        w1.x = cvt_pk_bf16(o[0][4 * rg + 2] * inv, o[1][4 * rg + 2] * inv); w1.y = cvt_pk_bf16(o[2][4 * rg + 2] * inv, o[3][4 * rg + 2] * inv);
        w1.z = cvt_pk_bf16(o[0][4 * rg + 3] * inv, o[1][4 * rg + 3] * inv); w1.w = cvt_pk_bf16(o[2][4 * rg + 3] * inv, o[3][4 * rg + 3] * inv);
        *(u32x4*)(qrow + 32 * rg + 16 * hi) = w0; *(u32x4*)(qrow + 32 * rg + 16 * hi + 8) = w1; }
    if (hi == 0) lse[(seqbase + ((size_t)lq << sh) + r) * 12 + h12] = m + log2f(lsum);
}
__device__ __forceinline__ void mem_attn_unit(const bf16_t* z, const bf16_t* KVb, bf16_t* afm, int unit, int lane) {
    const int h = unit >> 9, w = unit & 511;
    const int q = lane & 31, hi = lane >> 5;
    const bf16_t* qp = z + (size_t)(w * 32 + q) * NIN + 5632 + h * 256 + hi * 8;
    f32x16 o[8];
#pragma unroll
    for (int dt = 0; dt < 8; ++dt)
#pragma unroll
        for (int i = 0; i < 16; ++i) o[dt][i] = 0.f;
    float m = -1e30f, lsum = 0.f;
    const float sc = 0.0625f * LOG2E;
    for (int kt = 0; kt < 8; ++kt) {
        const bf16_t* kp = KVb + (size_t)(kt * 32 + q) * 2048 + h * 256 + hi * 8;
        f32x16 s;
#pragma unroll
        for (int i = 0; i < 16; ++i) s[i] = 0.f;
#pragma unroll
        for (int ks = 0; ks < 16; ++ks) { const bf16x8 kf = *(const bf16x8*)(kp + ks * 16); const bf16x8 qf = *(const bf16x8*)(qp + ks * 16); s = __builtin_amdgcn_mfma_f32_32x32x16_bf16(kf, qf, s, 0, 0, 0); }
        float mx = -1e30f;
#pragma unroll
        for (int i = 0; i < 16; ++i) { s[i] *= sc; mx = fmaxf(mx, s[i]); }
        mx = fmaxf(mx, __shfl_xor(mx, 32));
        const float mn = fmaxf(m, mx); const float f = __builtin_amdgcn_exp2f(m - mn); m = mn;
        float ps = 0.f;
#pragma unroll
        for (int i = 0; i < 16; ++i) { const float p = __builtin_amdgcn_exp2f(s[i] - mn); s[i] = p; ps += p; }
        lsum = lsum * f + ps;
#pragma unroll
        for (int dt = 0; dt < 8; ++dt)
#pragma unroll
            for (int i = 0; i < 16; ++i) o[dt][i] *= f;
        const bf16x8 pa0 = pack8(s, 0), pa1 = pack8(s, 8);
#pragma unroll
        for (int s_ = 0; s_ < 2; ++s_) {
            const bf16_t* vb = KVb + (size_t)(kt * 32) * 2048 + 1024 + h * 256 + 8 * q;
            u32x4 vv[8];
#pragma unroll
            for (int i = 0; i < 8; ++i) vv[i] = *(const u32x4*)(vb + (size_t)crow(8 * s_ + i, hi) * 2048);
#pragma unroll
            for (int dt = 0; dt < 8; ++dt) { u32x4 w;
                const unsigned sel = (dt & 1) ? 0x07060302u : 0x05040100u; const int c = dt >> 1;
                w.x = __builtin_amdgcn_perm(vv[1][c], vv[0][c], sel); w.y = __builtin_amdgcn_perm(vv[3][c], vv[2][c], sel); w.z = __builtin_amdgcn_perm(vv[5][c], vv[4][c], sel); w.w = __builtin_amdgcn_perm(vv[7][c], vv[6][c], sel);
                o[dt] = __builtin_amdgcn_mfma_f32_32x32x16_bf16(__builtin_bit_cast(bf16x8, w), s_ ? pa1 : pa0, o[dt], 0, 0, 0); }
        }
    }
    lsum += __shfl_xor(lsum, 32);
    const float inv = 1.0f / lsum;
    bf16_t* op = afm + (size_t)(w * 32 + q) * NAFM + 1536 + h * 256;
#pragma unroll
    for (int r = 0; r < 16; ++r) {
        u32x4 w; w.x = cvt_pk_bf16(o[0][r] * inv, o[1][r] * inv); w.y = cvt_pk_bf16(o[2][r] * inv, o[3][r] * inv); w.z = cvt_pk_bf16(o[4][r] * inv, o[5][r] * inv); w.w = cvt_pk_bf16(o[6][r] * inv, o[7][r] * inv);
        *(u32x4*)(op + 8 * crow(r, hi)) = w; }
}

__device__ __forceinline__ int t5_bucket(int rel) {
    const int n = rel < 0 ? -rel : rel; const float nf = (float)(n < 1 ? 1 : n);
    int large = 8 + (int)(logf(nf / 8.0f) / 4.852030263919617f * 8.0f); large = large < 15 ? large : 15;
    return (rel > 0 ? 16 : 0) + (n < 8 ? n : large);
}


#define XB_TMO      128
#define XB_XCNT(j)  (256  + 64 * (j))
#define XB_XSUB(j)  (1280 + 64 * (j))
#define XB_XGEN(j)  (2304 + 64 * (j))
#define XB_TOP      3328
#define XB_TOPGEN   3392
#define XCD_BAR_WORDS 3456
#define XB_SPIN_CAP (1u << 22)
__device__ __forceinline__ unsigned xb_ld(unsigned* p)              { return __hip_atomic_load(p, __ATOMIC_RELAXED, __HIP_MEMORY_SCOPE_AGENT); }
__device__ __forceinline__ unsigned xb_add(unsigned* p, unsigned v) { return __hip_atomic_fetch_add(p, v, __ATOMIC_RELAXED, __HIP_MEMORY_SCOPE_AGENT); }
__device__ __forceinline__ unsigned xb_xcc_id() { return (unsigned)__builtin_amdgcn_s_getreg((3 << 11) | 20) & 0xFu; }
#define XB_SPIN(cond, bar) do { unsigned _sp = 0; while (cond) { __builtin_amdgcn_s_sleep(1); \
    if ((++_sp & 255u) == 0u) { if (xb_ld(&(bar)[XB_TMO])) break; if (_sp > XB_SPIN_CAP) { atomicAdd(&(bar)[XB_TMO], 1u); break; } } } } while (0)
struct XcdBarrier { unsigned* bar; unsigned x; volatile LAS unsigned* st; };
__device__ __forceinline__ XcdBarrier xcd_barrier_post(unsigned* bar, volatile LAS unsigned* st) {
    XcdBarrier b; b.bar = bar; b.x = xb_xcc_id(); b.st = st;
    if (threadIdx.x == 0) (void)xb_add(&bar[XB_XCNT(b.x)], 1u);
    return b;
}
__device__ __forceinline__ void xcd_barrier_complete(unsigned* bar, unsigned x, unsigned& nloc, unsigned& nx) {
    const unsigned G = gridDim.x * gridDim.y * gridDim.z;
    unsigned sum, cnt, mine, sp = 0u;
    for (;;) {
        sum = 0u; cnt = 0u; mine = 0u;
#pragma unroll
        for (unsigned j = 0; j < 16; ++j) { const unsigned c = xb_ld(&bar[XB_XCNT(j)]); sum += c; cnt += (c > 0u) ? 1u : 0u; mine = (j == x) ? c : mine; }
        if (sum == G) break;
        __builtin_amdgcn_s_sleep(1);
        if ((++sp & 255u) == 0u) { if (xb_ld(&bar[XB_TMO])) break; if (sp > XB_SPIN_CAP) { atomicAdd(&bar[XB_TMO], 1u); break; } }
    }
    nloc = mine > 0u ? mine : 1u; nx = cnt > 0u ? cnt : 1u;
}
__device__ __forceinline__ void xcd_barrier(const XcdBarrier& b) {
    asm volatile("s_waitcnt vmcnt(0)" ::: "memory");
    __syncthreads();
    if (threadIdx.x == 0) {
        unsigned* bar = b.bar;
        __builtin_amdgcn_s_waitcnt(0);
        unsigned nloc = b.st[0], nx = b.st[1];
        if (nloc == 0u) { xcd_barrier_complete(bar, b.x, nloc, nx); b.st[0] = nloc; b.st[1] = nx; }
        const unsigned old = xb_add(&bar[XB_XSUB(b.x)], 1u);
        const unsigned gen = old / nloc;
        if (old + 1u == (gen + 1u) * nloc) {
            __builtin_amdgcn_fence(__ATOMIC_RELEASE, "agent");
            asm volatile("s_waitcnt vmcnt(0)" ::: "memory");
            const unsigned og = xb_add(&bar[XB_TOP], 1u);
            const unsigned tg = og / nx;
            if (og + 1u == (tg + 1u) * nx) xb_add(&bar[XB_TOPGEN], 1u);
            else XB_SPIN(xb_ld(&bar[XB_TOPGEN]) == tg, bar);
            __builtin_amdgcn_fence(__ATOMIC_ACQUIRE, "agent");
            xb_add(&bar[XB_XGEN(b.x)], 1u);
            asm volatile("s_waitcnt vmcnt(0)" ::: "memory");
        } else {
            XB_SPIN(xb_ld(&bar[XB_XGEN(b.x)]) == gen, bar);
            __builtin_amdgcn_fence(__ATOMIC_ACQUIRE, "agent");
            asm volatile("s_waitcnt vmcnt(0)" ::: "memory");
        }
    }
    __syncthreads();
}

struct Args { const float* in[24]; float* out; unsigned char* ws; int ph_lo, ph_hi, coop, pad; };
constexpr int N_PHASES = 25;

__global__ void __launch_bounds__(512, 2) mk_fwd(Args args) {
    extern __shared__ __attribute__((aligned(16))) unsigned char lds_raw[];
    LAS unsigned char* lds = (LAS unsigned char*)lds_raw;
    const int G = gridDim.x, bx = blockIdx.x;
    unsigned char* ws = args.ws;
    float* out = args.out;
    bf16_t* XN = (bf16_t*)(ws + WS_XN); bf16_t* Hb = (bf16_t*)(ws + WS_H);
    bf16_t* ZG = (bf16_t*)(ws + WS_ZG); bf16_t* GG = (bf16_t*)(ws + WS_GG); bf16_t* AFM = (bf16_t*)(ws + WS_AFM); bf16_t* YT = (bf16_t*)(ws + WS_YT); float* LSE = (float*)(ws + WS_LSE);
    bf16_t* DS2 = (bf16_t*)(ws + WS_DS2); bf16_t* DS4 = (bf16_t*)(ws + WS_DS4); bf16_t* D256 = (bf16_t*)(ws + WS_D256);
    bf16_t* MEMN = (bf16_t*)(ws + WS_MEMN); bf16_t* KV = (bf16_t*)(ws + WS_KV);
#if MK_COOP
    cg::grid_group grid = cg::this_grid();
    volatile LAS unsigned* xst = (volatile LAS unsigned*)(lds + 139264 + 64);
    if (threadIdx.x < 2) xst[threadIdx.x] = 0u;
    __syncthreads();
    const XcdBarrier xbar = xcd_barrier_post((unsigned*)ws, xst);
#endif

#ifndef PROBE_MASK
#define PROBE_MASK 0u
#endif
    for (int pi = args.ph_lo; pi < args.ph_hi; ++pi) {
        int ph = 0; { int acc_ = 0; for (int p_ = 0; p_ < N_PHASES; ++p_) { const int w_ = 1 + (int)((PROBE_MASK >> p_) & 1u); if (pi >= acc_ && pi < acc_ + w_) ph = p_; acc_ += w_; } }
        int tid = threadIdx.x; asm volatile("" : "+v"(tid));
        const int lane = tid & 63, wave = __builtin_amdgcn_readfirstlane(tid >> 6);
        const int gw = bx * 8 + wave, ngw = G * 8;
        const bool mix = (ph >= 4 && ph < 22);
        const int chunk = mix ? (ph - 4) / 6 : 0, mk = mix ? (ph - 4) % 6 : -1;
        const int S = (chunk == 2) ? 4096 : 2048, nseq = (chunk == 2) ? 4 : 8;
        const size_t crow0 = (size_t)chunk * CH;

        if (ph == 0) {
            LAS float* scr = (LAS float*)(lds + wave * 17408);
            convert_weight(args.in[6], DM, 2 * DFF, (bf16_t*)(ws + WS_W1U), DM, 0, true, scr, gw, ngw, lane);
            convert_weight(args.in[7], DFF, DM, (bf16_t*)(ws + WS_W1D), DFF, 0, false, scr, gw, ngw, lane);
            convert_weight(args.in[11], DM, NIN, (bf16_t*)(ws + WS_WIN), DM, 0, false, scr, gw, ngw, lane);
            convert_weight(args.in[13], DM, NGT, (bf16_t*)(ws + WS_WG), DM, 0, false, scr, gw, ngw, lane);
            convert_weight(args.in[12], DM, DM, (bf16_t*)(ws + WS_WKV), DM, 0, false, scr, gw, ngw, lane);
            convert_weight(args.in[15], 512, DM, (bf16_t*)(ws + WS_WP), NAFM, 0, false, scr, gw, ngw, lane);
            convert_weight(args.in[16], 1024, DM, (bf16_t*)(ws + WS_WP), NAFM, 512, false, scr, gw, ngw, lane);
            convert_weight(args.in[17], 1024, DM, (bf16_t*)(ws + WS_WP), NAFM, 1536, false, scr, gw, ngw, lane);
            convert_weight(args.in[18], DM, DM, (bf16_t*)(ws + WS_WO), DM, 0, false, scr, gw, ngw, lane);
            for (int row = gw; row < TT; row += ngw) {
                const float* xr = (row < TP) ? args.in[0] + (size_t)row * DM : args.in[1] + (size_t)(row - TP) * DM;
                row_op<false, false>(nullptr, xr, nullptr, XN + (size_t)row * DM, nullptr, args.in[5], 0.f, lane);
            }
        }
#ifndef DIS_G1
        if (ph == 1 || ph == 22) {
            SchedStd Sd; Sd.so.init(TT, 2 * DFF, G, bx); Sd.A = (const char*)XN; Sd.B = (const char*)(ws + WS_W1U); Sd.C = Hb;
            Sd.a_tile = (size_t)256 * DM * 2; Sd.b_tile = (size_t)256 * DM * 2; Sd.ldc = DFF; Sd.ccols = 128; Sd.nt = DM / 64;
            pg8::EpiSwiGLU E{DFF};
            pg8::gemm_phase<pg8::EpiSwiGLU, SchedStd>(lds, tid, DM, DM, Sd, E);
        }
#endif
#ifndef DIS_G2
        if (ph == 2 || ph == 23 || mk == 0 || mk == 4) {
            const int nrep = (mk == 0) ? (bx >= 128 ? 3 : 2) : 1;
            for (int rep = 0; rep < nrep; ++rep) {
                SchedStd Sd; int lda, ldb;
                if (ph == 2 || ph == 23) { Sd.so.init(TT, DM, G, bx); Sd.A = (const char*)Hb; Sd.B = (const char*)(ws + WS_W1D); Sd.C = XN; lda = DFF; ldb = DFF; Sd.ldc = DM; Sd.nt = DFF / 64; }
                else if (mk == 0 && rep == 0) { Sd.so.init(CH, NIN, G, bx); Sd.A = (const char*)(XN + crow0 * DM); Sd.B = (const char*)(ws + WS_WIN); Sd.C = ZG; lda = DM; ldb = DM; Sd.ldc = NIN; Sd.nt = DM / 64; }
                else if (mk == 0 && rep == 1) { Sd.so.init(CH, NGT, G, bx); Sd.A = (const char*)(XN + crow0 * DM); Sd.B = (const char*)(ws + WS_WG); Sd.C = GG; lda = DM; ldb = DM; Sd.ldc = NGT; Sd.nt = DM / 64; }
                else if (mk == 0) { const int mrow0 = (chunk == 2 ? 16 : chunk * 8) * 256; Sd.so.init(nseq * 256, DM, G - 128, bx - 128); Sd.A = (const char*)(MEMN + (size_t)mrow0 * DM); Sd.B = (const char*)(ws + WS_WKV); Sd.C = KV + (size_t)mrow0 * DM; lda = DM; ldb = DM; Sd.ldc = DM; Sd.nt = DM / 64; }
                else { Sd.so.init(CH, DM, G, bx); Sd.A = (const char*)GG; Sd.B = (const char*)(ws + WS_WO); Sd.C = YT; lda = NGT; ldb = DM; Sd.ldc = DM; Sd.nt = DM / 64; }
                Sd.a_tile = (size_t)256 * lda * 2; Sd.b_tile = (size_t)256 * ldb * 2; Sd.ccols = 256;
                pg8::EpiStore<0> E{Sd.ldc, nullptr};
                pg8::gemm_phase<pg8::EpiStore<0>, SchedStd>(lds, tid, lda, ldb, Sd, E);
            }
        }
#endif
#ifndef DIS_R3
        if (ph == 3) {
            for (int row = gw; row < TT; row += ngw) {
                const float* xr = (row < TP) ? args.in[0] + (size_t)row * DM : args.in[1] + (size_t)(row - TP) * DM;
                row_op<false, true>(XN + (size_t)row * DM, xr, out + (size_t)row * DM, XN + (size_t)row * DM, args.in[8], args.in[9], 0.5f, lane);
            }
            for (int row = gw; row < 5120; row += ngw) {
                const float* xr = (row < 4096) ? args.in[2] + (size_t)row * DM : args.in[3] + (size_t)(row - 4096) * DM;
                row_op<false, false>(nullptr, xr, nullptr, MEMN + (size_t)row * DM, nullptr, args.in[10], 0.f, lane);
            }
            { LAS float* scr = (LAS float*)(lds + wave * 17408);
              convert_weight(args.in[21], DM, 2 * DFF, (bf16_t*)(ws + WS_W1U), DM, 0, true, scr, gw, ngw, lane);
              convert_weight(args.in[22], DFF, DM, (bf16_t*)(ws + WS_W1D), DFF, 0, false, scr, gw, ngw, lane); }
            const int gt = bx * 512 + tid, ngt = G * 512;
            LAS float* ctab = (LAS float*)lds;
            for (int which = 0; which < 2; ++which) {
                const int SS = which ? 4096 : 2048; bf16_t* DS = which ? DS4 : DS2; const float scl = which ? 0.015625f : 0.022097086912079608f; const float inv = 2.0f / (float)SS;
                __syncthreads();
                for (int m_ = tid; m_ < SS; m_ += 512) ctab[m_] = cospif((float)m_ * inv) * scl;
                __syncthreads();
                const int per_row = (2 * SS) / 8, total = SS * per_row;
                for (int idx = gt; idx < total; idx += ngt) { const int j = idx / per_row, k8 = (idx - j * per_row) * 8; float vv[8];
#pragma unroll
                    for (int e = 0; e < 8; ++e) { const int k = k8 + e; const int kk = k & (SS - 1); const int mm = (j * kk + ((k >= SS) ? (SS >> 2) : 0)) & (SS - 1); vv[e] = ctab[mm]; }
                    u32x4 w; w.x = cvt_pk_bf16(vv[0], vv[1]); w.y = cvt_pk_bf16(vv[2], vv[3]); w.z = cvt_pk_bf16(vv[4], vv[5]); w.w = cvt_pk_bf16(vv[6], vv[7]);
                    *(u32x4*)(DS + (size_t)j * (2 * SS) + k8) = w; }
            }
            __syncthreads();
            for (int idx = gt; idx < 512 * 256 / 8; idx += ngt) { const int mrow = idx / 32, c8 = (idx - mrow * 32) * 8; float vv[8];
#pragma unroll
                for (int e = 0; e < 8; ++e) { const int cc = c8 + e; const int mm = ((mrow & 255) * cc) & 255; const float x = (float)mm * (2.0f / 256.0f);
                    vv[e] = (mrow >= 256) ? sinpif(x) * 0.0625f : cospif(x) * 0.0625f; }
                u32x4 w; w.x = cvt_pk_bf16(vv[0], vv[1]); w.y = cvt_pk_bf16(vv[2], vv[3]); w.z = cvt_pk_bf16(vv[4], vv[5]); w.w = cvt_pk_bf16(vv[6], vv[7]);
                *(u32x4*)(D256 + (size_t)mrow * 256 + c8) = w; }
        }
#endif
#ifndef DIS_M1
        if (mk == 1) {
#ifndef DIS_F1
            { SchedF1 Sf{(const char*)D256, (const char*)ZG, YT, S, nseq * 4 * 2 * (S >> 8), G, bx};
              pg8::EpiStore<0> E{2 * S, nullptr};
              pg8::gemm_phase<pg8::EpiStore<0>, SchedF1>(lds, tid, 256, NIN, Sf, E); }
#endif
            LAS float* biasL = (LAS float*)lds;
#ifndef DIS_BIAS
            for (int idx = tid; idx < 12 * 129; idx += 512) { const int h12 = idx / 129, dd = idx - h12 * 129 - 64; const int g = h12 >> 2;
                biasL[h12 * 132 + dd + 64] = args.in[4][t5_bucket(dd * (1 << (2 * g))) * 12 + h12] * LOG2E; }
#endif
            __syncthreads();
#ifndef DIS_DIL
            for (int u = gw; u < 12 * 512; u += ngw) dil_attn_unit(ZG, LSE, biasL, S, u, lane);
#endif
#ifndef DIS_MEM
            for (int u = gw; u < 4 * 512; u += ngw) { const int w = u & 511; const int bglob = (chunk == 2 ? 16 : chunk * 8) + (w * 32) / S;
                mem_attn_unit(ZG, KV + (size_t)bglob * 256 * 2048, AFM, u, lane); }
#endif
            __syncthreads();
        }
#endif
#ifndef DIS_M2
        if (mk == 2) {
            { SchedF2 Sf{(const char*)(chunk == 2 ? DS4 : DS2), (const char*)YT, AFM, S, nseq * (S >> 8) * 4, G, bx};
              pg8::EpiStore<0> E{NAFM, nullptr};
              pg8::gemm_phase<pg8::EpiStore<0>, SchedF2>(lds, tid, 2 * S, 2 * S, Sf, E); }
            for (int t = gw; t < CH; t += ngw) { const int j = lane >> 4, e0 = (lane & 15) * 8;
                const float l0 = LSE[(size_t)t * 12 + j], l1 = LSE[(size_t)t * 12 + 4 + j], l2 = LSE[(size_t)t * 12 + 8 + j];
                const float mxl = fmaxf(l0, fmaxf(l1, l2)); float w0 = __builtin_amdgcn_exp2f(l0 - mxl), w1 = __builtin_amdgcn_exp2f(l1 - mxl), w2 = __builtin_amdgcn_exp2f(l2 - mxl);
                const float iw = 1.0f / (w0 + w1 + w2); w0 *= iw; w1 *= iw; w2 *= iw;
                const bf16_t* zr = ZG + (size_t)t * NIN + j * 128 + e0;
                const u32x4 a = *(const u32x4*)zr, b = *(const u32x4*)(zr + 512), c = *(const u32x4*)(zr + 1024);
                u32x4 o;
                o.x = cvt_pk_bf16(w0 * bf_lo(a.x) + w1 * bf_lo(b.x) + w2 * bf_lo(c.x), w0 * bf_hi(a.x) + w1 * bf_hi(b.x) + w2 * bf_hi(c.x));
                o.y = cvt_pk_bf16(w0 * bf_lo(a.y) + w1 * bf_lo(b.y) + w2 * bf_lo(c.y), w0 * bf_hi(a.y) + w1 * bf_hi(b.y) + w2 * bf_hi(c.y));
                o.z = cvt_pk_bf16(w0 * bf_lo(a.z) + w1 * bf_lo(b.z) + w2 * bf_lo(c.z), w0 * bf_hi(a.z) + w1 * bf_hi(b.z) + w2 * bf_hi(c.z));
                o.w = cvt_pk_bf16(w0 * bf_lo(a.w) + w1 * bf_lo(b.w) + w2 * bf_lo(c.w), w0 * bf_hi(a.w) + w1 * bf_hi(b.w) + w2 * bf_hi(c.w));
                *(u32x4*)(AFM + (size_t)t * NAFM + j * 128 + e0) = o; }
        }
#endif
#ifndef DIS_M4
        if (mk == 3) {
            SchedP Sp; Sp.so.init(CH, DM, G, bx); Sp.AFM = (const char*)AFM; Sp.WP = (const char*)(ws + WS_WP); Sp.Gc = GG;
            pg8::EpiGateRMW E{NGT, args.in[14]};
            pg8::gemm_phase<pg8::EpiGateRMW, SchedP>(lds, tid, NAFM, NAFM, Sp, E);
        }
#endif
#ifndef DIS_R6
        if (mk == 5 || ph == 24) {
            const int r0 = (ph == 24) ? 0 : (int)crow0, nr = (ph == 24) ? TT : CH;
            for (int row = gw; row < nr; row += ngw) { const size_t gr = (size_t)(r0 + row);
                const bf16_t* yr = (ph == 24) ? XN + gr * DM : YT + (size_t)row * DM;
                if (ph == 24) row_op<true, false>(yr, out + gr * DM, out + gr * DM, nullptr, args.in[23], args.in[20], 0.5f, lane);
                else row_op<true, true>(yr, out + gr * DM, out + gr * DM, XN + gr * DM, args.in[19], args.in[20], 1.0f, lane); }
        }
#endif

#if MK_COOP
        if (pi + 1 < args.ph_hi) { if (pi == args.ph_lo) grid.sync(); else xcd_barrier(xbar); }
#endif
    }
}

extern "C" void kernel_launch(void* const* d_in, const int* in_sizes, int n_in, void* d_out, int out_size, void* d_ws, size_t ws_size, hipStream_t stream) {
    static int grid = 0;
    if (grid == 0) {
        if (n_in != 24 || out_size != TT * DM || ws_size < WS_END) { fprintf(stderr, "kernel_launch: unexpected shapes (n_in %d out %d ws %zu)\n", n_in, out_size, ws_size); grid = -1; return; }
        int dev = 0, cus = 0, per_cu = 0;
        hipGetDevice(&dev); hipDeviceGetAttribute(&cus, hipDeviceAttributeMultiprocessorCount, dev);
        if (hipFuncSetAttribute((const void*)mk_fwd, hipFuncAttributeMaxDynamicSharedMemorySize, LDS_BYTES) != hipSuccess) { fprintf(stderr, "kernel_launch: hipFuncSetAttribute failed\n"); grid = -1; return; }
        if (hipOccupancyMaxActiveBlocksPerMultiprocessor(&per_cu, (const void*)mk_fwd, 512, LDS_BYTES) != hipSuccess || per_cu < 1) { fprintf(stderr, "kernel_launch: occupancy query says %d\n", per_cu); per_cu = 1; }
        (void)hipGetLastError();
        grid = cus * 1;
    }
    if (grid < 0) return;
    Args a{};
    for (int i = 0; i < 24; ++i) a.in[i] = (const float*)d_in[i];
    a.out = (float*)d_out; a.ws = (unsigned char*)d_ws;
#if MK_COOP
    (void)hipMemsetAsync(d_ws, 0, 16384, stream);
    a.ph_lo = 0; a.ph_hi = N_PHASES + __builtin_popcount(PROBE_MASK); a.coop = 1;
    void* kargs[] = {&a};
    hipError_t e = hipLaunchCooperativeKernel((const void*)mk_fwd, dim3(grid), dim3(512), kargs, LDS_BYTES, stream);
    if (e != hipSuccess) fprintf(stderr, "cooperative launch failed: %s (grid %d)\n", hipGetErrorString(e), grid);
#else
    for (int ph = 0; ph < N_PHASES; ++ph) {
        a.ph_lo = ph; a.ph_hi = ph + 1; a.coop = 0;
        hipLaunchKernelGGL(mk_fwd, dim3(grid), dim3(512), LDS_BYTES, stream, a);
    }
#endif
}
```

```cpp
#include <hip/hip_runtime.h>
#include <hip/hip_cooperative_groups.h>
#include <cstdio>
#include <cstdint>
namespace cg = cooperative_groups;

#ifndef MK_COOP
#define MK_COOP 1
#endif

#define LAS __attribute__((address_space(3)))
typedef unsigned short bf16_t;
typedef short bf16x8 __attribute__((ext_vector_type(8)));
typedef float f32x4 __attribute__((ext_vector_type(4)));
typedef float f32x16 __attribute__((ext_vector_type(16)));
typedef unsigned u32x4 __attribute__((ext_vector_type(4)));
typedef unsigned u32x2 __attribute__((ext_vector_type(2)));

constexpr int TT = 49152, DM = 2048, DFF = 5632, NIN = 6656, NGT = 6144, CH = 16384, NAFM = 2560;
constexpr int TP = 32768;
constexpr float RMS_EPS = 1e-6f;
constexpr float LOG2E = 1.4426950408889634f;
constexpr size_t MiB = 1u << 20;
constexpr size_t WS_W1U = 1 * MiB;
constexpr size_t WS_W1D = WS_W1U + 44 * MiB;
constexpr size_t WS_YT = WS_W1D + 22 * MiB;
constexpr size_t WS_WIN = WS_YT + 66 * MiB;
constexpr size_t WS_WG = WS_WIN + 26 * MiB;
constexpr size_t WS_WKV = WS_WG + 24 * MiB;
constexpr size_t WS_WP = WS_WKV + 8 * MiB;
constexpr size_t WS_WO = WS_WP + 10 * MiB;
constexpr size_t WS_XN = WS_WO + 8 * MiB;
constexpr size_t WS_H = WS_XN + 192 * MiB;
constexpr size_t WS_ZG = WS_H;
constexpr size_t WS_GG = WS_ZG + 208 * MiB;
constexpr size_t WS_AFM = WS_GG + 192 * MiB;
constexpr size_t WS_LSE = WS_AFM + 80 * MiB;
constexpr size_t WS_MEMN = WS_LSE + 1 * MiB;
constexpr size_t WS_KV = WS_MEMN + 20 * MiB;
constexpr size_t WS_HEND = WS_H + 528 * MiB;
static_assert(WS_KV + 20 * MiB <= WS_HEND, "overlay map");
constexpr size_t WS_DS2 = WS_HEND;
constexpr size_t WS_DS4 = WS_DS2 + 8 * MiB;
constexpr size_t WS_D256 = WS_DS4 + 32 * MiB;
constexpr size_t WS_YF = WS_D256 + 1 * MiB;
constexpr size_t WS_END = WS_YF + 32 * MiB;
static_assert(WS_END <= 1024 * MiB, "workspace");

constexpr int LDS_BYTES = 140288;

__device__ __forceinline__ unsigned cvt_pk_bf16(float lo, float hi) { unsigned r; asm volatile("v_cvt_pk_bf16_f32 %0, %1, %2" : "=v"(r) : "v"(lo), "v"(hi)); return r; }
__device__ __forceinline__ float bf_lo(unsigned u) { return __uint_as_float(u << 16); }
__device__ __forceinline__ float bf_hi(unsigned u) { return __uint_as_float(u & 0xffff0000u); }
__device__ __forceinline__ float wave_sum(float v) {
#pragma unroll
    for (int o = 1; o < 64; o <<= 1) v += __shfl_xor(v, o);
    return v;
}
__device__ __forceinline__ float sigmoidf_(float x) { return __builtin_amdgcn_rcpf(1.0f + __builtin_amdgcn_exp2f(-x * LOG2E)); }

namespace pg8 {
constexpr int BM = 256, BK = 64, HALF = 128, HTB = HALF * BK * 2, STAGE_BYTES = 8 * HTB, NXCD = 8, WGM = 4;
__host__ __device__ __forceinline__ int lds_byte(int r, int c) { const int st = (r >> 4) * 2 + (c >> 5), rr = r & 15, cc = c & 31, ob = rr * 64 + cc * 2; return st * 1024 + (ob ^ (((ob >> 9) & 1) << 5)); }
__host__ __device__ __forceinline__ void stage_rc(int b, int& R, int& C) { const int st = b / 1024, sb = b % 1024, swz = sb ^ (((sb >> 9) & 1) << 5); R = (st >> 1) * 16 + swz / 64; C = (st & 1) * 32 + (swz % 64) / 2; }
__host__ __device__ __forceinline__ int perm32(int rho) { const int n = rho >> 4, i = rho & 15; return 8 * (i >> 2) + 4 * n + (i & 3); }

struct Unit { const char* A; const char* B; bf16_t* C; const bf16_t* C2; int nt; int aux; };
struct PN { int pm, pn; };
struct StaticOrder {
    int nM, nN, nwg, G, c;
    __device__ void init(int M, int N, int G_, int c_) { nM = M / BM; nN = N / BM; nwg = nM * nN; G = G_; c = c_; }
    __device__ bool next(int i, PN& u) const {
        const long L = (long)i * G + c; if (L >= nwg) return false;
        int wgid = (int)L; { const int q = nwg / NXCD, r = nwg % NXCD, xcd = wgid % NXCD, off = wgid / NXCD; wgid = (xcd < r ? xcd * (q + 1) : r * (q + 1) + (xcd - r) * q) + off; }
        const int nig = WGM * nN, gid = wgid / nig, fm = gid * WGM, gsz = (nM - fm) < WGM ? (nM - fm) : WGM;
        u.pm = fm + ((wgid % nig) % gsz); u.pn = (wgid % nig) / gsz; return true;
    }
};

template <int ACT> struct EpiStore {
    int ldc; const float* bias;
    __device__ __forceinline__ void operator()(const f32x4 (&acc)[2][2][4][2], const Unit& u, int wr, int wc, int fr, int fq) const {
        bf16_t* base = u.C + (size_t)(wr * 64 + fr) * ldc + wc * 32 + 8 * fq;
        f32x4 bv[2][2];
        if (ACT == 1) {
#pragma unroll
            for (int bj = 0; bj < 2; ++bj)
#pragma unroll
                for (int n = 0; n < 2; ++n) bv[bj][n] = *(const f32x4*)(bias + u.aux + bj * HALF + wc * 32 + 8 * fq + 4 * n);
        }
#pragma unroll
        for (int ai = 0; ai < 2; ++ai)
#pragma unroll
            for (int m = 0; m < 4; ++m) { bf16_t* rowp = base + (size_t)(ai * HALF + m * 16) * ldc;
#pragma unroll
                for (int bj = 0; bj < 2; ++bj) { f32x4 v0 = acc[ai][bj][m][0], v1 = acc[ai][bj][m][1];
                    if (ACT == 1) { v0 = v0 + bv[bj][0]; v1 = v1 + bv[bj][1];
#pragma unroll
                        for (int e = 0; e < 4; ++e) { v0[e] = sigmoidf_(v0[e]); v1[e] = sigmoidf_(v1[e]); } }
                    u32x4 w; w.x = cvt_pk_bf16(v0[0], v0[1]); w.y = cvt_pk_bf16(v0[2], v0[3]); w.z = cvt_pk_bf16(v1[0], v1[1]); w.w = cvt_pk_bf16(v1[2], v1[3]);
                    *(u32x4*)(rowp + bj * HALF) = w; } }
    }
};
struct EpiSwiGLU {
    int ldc;
    __device__ __forceinline__ void operator()(const f32x4 (&acc)[2][2][4][2], const Unit& u, int wr, int wc, int fr, int fq) const {
        bf16_t* base = u.C + (size_t)(wr * 64 + fr) * ldc + wc * 32 + 8 * fq;
#pragma unroll
        for (int ai = 0; ai < 2; ++ai)
#pragma unroll
            for (int m = 0; m < 4; ++m) { bf16_t* rowp = base + (size_t)(ai * HALF + m * 16) * ldc;
                f32x4 v0, v1;
#pragma unroll
                for (int e = 0; e < 4; ++e) { const float a0 = acc[ai][0][m][0][e], a1 = acc[ai][0][m][1][e];
                    v0[e] = a0 * sigmoidf_(a0) * acc[ai][1][m][0][e]; v1[e] = a1 * sigmoidf_(a1) * acc[ai][1][m][1][e]; }
                u32x4 w; w.x = cvt_pk_bf16(v0[0], v0[1]); w.y = cvt_pk_bf16(v0[2], v0[3]); w.z = cvt_pk_bf16(v1[0], v1[1]); w.w = cvt_pk_bf16(v1[2], v1[3]);
                *(u32x4*)rowp = w; }
    }
};
struct EpiGateRMW {
    int ldc; const float* bias; int ldg;
    __device__ __forceinline__ void operator()(const f32x4 (&acc)[2][2][4][2], const Unit& u, int wr, int wc, int fr, int fq) const {
        const size_t off0 = (size_t)(wr * 64 + fr) * ldc + wc * 32 + 8 * fq, goff0 = (size_t)(wr * 64 + fr) * ldg + wc * 32 + 8 * fq;
        f32x4 bv[2][2];
#pragma unroll
        for (int bj = 0; bj < 2; ++bj)
#pragma unroll
            for (int n = 0; n < 2; ++n) bv[bj][n] = *(const f32x4*)(bias + (u.aux >> 2) + bj * HALF + wc * 32 + 8 * fq + 4 * n);
#pragma unroll
        for (int ai = 0; ai < 2; ++ai)
#pragma unroll
            for (int m = 0; m < 4; ++m) { const size_t ro = off0 + (size_t)(ai * HALF + m * 16) * ldc, go = goff0 + (size_t)(ai * HALF + m * 16) * ldg;
#pragma unroll
                for (int bj = 0; bj < 2; ++bj) {
                    const u32x4 g = *(const u32x4*)(u.C2 + go + bj * HALF);
                    u32x4 o = (u32x4){0u, 0u, 0u, 0u}; if (u.aux & 3) o = *(const u32x4*)(u.C + ro + bj * HALF);
                    const f32x4 a0 = acc[ai][bj][m][0], a1 = acc[ai][bj][m][1];
                    const f32x4 b0 = bv[bj][0], b1 = bv[bj][1];
                    u32x4 w;
                    w.x = cvt_pk_bf16(bf_lo(o.x) + sigmoidf_(bf_lo(g.x) + b0[0]) * a0[0], bf_hi(o.x) + sigmoidf_(bf_hi(g.x) + b0[1]) * a0[1]);
                    w.y = cvt_pk_bf16(bf_lo(o.y) + sigmoidf_(bf_lo(g.y) + b0[2]) * a0[2], bf_hi(o.y) + sigmoidf_(bf_hi(g.y) + b0[3]) * a0[3]);
                    w.z = cvt_pk_bf16(bf_lo(o.z) + sigmoidf_(bf_lo(g.z) + b1[0]) * a1[0], bf_hi(o.z) + sigmoidf_(bf_hi(g.z) + b1[1]) * a1[1]);
                    w.w = cvt_pk_bf16(bf_lo(o.w) + sigmoidf_(bf_lo(g.w) + b1[2]) * a1[2], bf_hi(o.w) + sigmoidf_(bf_hi(g.w) + b1[3]) * a1[3]);
                    *(u32x4*)(u.C + ro + bj * HALF) = w; } }
    }
};

template <class Epi, class Sched>
__device__ __forceinline__ void gemm_phase(LAS unsigned char* lds, const int tid, const int lda, const int ldb, const Sched& S, const Epi& E) {
    const int wid = __builtin_amdgcn_readfirstlane(tid >> 6), lane = tid & 63, wr = wid >> 2, wc = wid & 3, fr = lane & 15, fq = lane >> 4;
    unsigned voffA[2], voffB[2];
#pragma unroll
    for (int i = 0; i < 2; ++i) { int R, C; stage_rc(tid * 16 + i * 8192, R, C); const int Rb = (R & ~31) + perm32(R & 31);
        voffA[i] = (unsigned)(R * lda + C) * 2u; voffB[i] = (unsigned)(Rb * ldb + C) * 2u; }
    const size_t kstep = (size_t)(BK * 2);
    const size_t hstepA = (size_t)HALF * lda * 2, hstepB = (size_t)HALF * ldb * 2;
    const unsigned ldsw = (unsigned)wid * 1024u;
    const int aoff = lds_byte(wr * 64 + fr, fq * 8), boff = lds_byte(wc * 32 + fr, fq * 8);
#define PG8_SA(b, h) (((b) * 2 + (h)) * HTB)
#define PG8_SB(b, h) ((4 + (b) * 2 + (h)) * HTB)
#define PG8_STAGE(bufoff, gbase, voff) do { _Pragma("unroll") for (int _i = 0; _i < 2; ++_i) \
        __builtin_amdgcn_global_load_lds((const unsigned*)((const char*)(gbase) + (voff)[_i]), (LAS unsigned*)(lds + (bufoff) + ldsw + _i * 8192), 16, 0, 0); } while (0)
#define PG8_LDA(dst, b, h) do { _Pragma("unroll") for (int m = 0; m < 4; ++m) _Pragma("unroll") for (int k = 0; k < 2; ++k) dst[m][k] = *(const LAS bf16x8*)(lds + PG8_SA(b, h) + aoff + m * 2048 + k * 1024); } while (0)
#define PG8_LDB(dst, b, h) do { _Pragma("unroll") for (int n = 0; n < 2; ++n) _Pragma("unroll") for (int k = 0; k < 2; ++k) dst[n][k] = *(const LAS bf16x8*)(lds + PG8_SB(b, h) + boff + n * 2048 + k * 1024); } while (0)
#define PG8_MMA(ai, bj, At, Bt) do { __builtin_amdgcn_s_setprio(1); _Pragma("unroll") for (int m = 0; m < 4; ++m) _Pragma("unroll") for (int n = 0; n < 2; ++n) _Pragma("unroll") for (int k = 0; k < 2; ++k) \
        acc[ai][bj][m][n] = __builtin_amdgcn_mfma_f32_16x16x32_bf16(Bt[n][k], At[m][k], acc[ai][bj][m][n], 0, 0, 0); __builtin_amdgcn_s_setprio(0); } while (0)
#define PG8_WAIT_V(n) asm volatile("s_waitcnt vmcnt(" #n ")" ::: "memory")
#define PG8_WAIT_L(n) asm volatile("s_waitcnt lgkmcnt(" #n ")" ::: "memory")
#define PG8_BAR __builtin_amdgcn_s_barrier()
#define PG8_SCHED __builtin_amdgcn_sched_barrier(0)
    Unit cur, nxt; int ui = 0;
    if (!S.next(0, cur)) return;
    f32x4 acc[2][2][4][2];
#pragma unroll
    for (int a = 0; a < 2; ++a)
#pragma unroll
        for (int b = 0; b < 2; ++b)
#pragma unroll
            for (int m = 0; m < 4; ++m)
#pragma unroll
                for (int n = 0; n < 2; ++n) acc[a][b][m][n] = (f32x4){0.f, 0.f, 0.f, 0.f};
    bf16x8 At[4][2], B0[2][2], B1[2][2];
    const char* cA = cur.A; const char* cB = cur.B;
    PG8_STAGE(PG8_SB(0, 0), cB, voffB); PG8_STAGE(PG8_SB(0, 1), cB + hstepB, voffB); PG8_STAGE(PG8_SA(0, 0), cA, voffA); PG8_STAGE(PG8_SA(0, 1), cA + hstepA, voffA);
    if (wr == 1) PG8_BAR;
    PG8_WAIT_V(2); PG8_BAR;
    PG8_STAGE(PG8_SB(1, 0), cB + kstep, voffB); PG8_STAGE(PG8_SA(1, 0), cA + kstep, voffA); PG8_STAGE(PG8_SB(1, 1), cB + hstepB + kstep, voffB);
    PG8_WAIT_V(6); PG8_BAR;
    for (;;) {
        const bool has_next = S.next(ui + 1, nxt);
        const char* nA = has_next ? nxt.A : cA; const char* nB = has_next ? nxt.B : cB;
        int nt = cur.nt; asm volatile("" : "+s"(nt));
        for (int t = 0; t < nt; t += 2) {
            const bool last = (t == nt - 2);
            const char* a1 = cA + (size_t)(t + 1) * kstep;
            const char* a2 = last ? nA : cA + (size_t)(t + 2) * kstep; const char* b2 = last ? nB : cB + (size_t)(t + 2) * kstep;
            const char* a3 = a2 + kstep; const char* b3 = b2 + kstep;
            PG8_LDB(B0, 0, 0); PG8_LDB(B1, 0, 1); PG8_SCHED; PG8_LDA(At, 0, 0); PG8_STAGE(PG8_SA(1, 1), a1 + hstepA, voffA);
            PG8_WAIT_V(8); PG8_WAIT_L(0); PG8_BAR; PG8_MMA(0, 0, At, B0); PG8_MMA(0, 1, At, B1); PG8_BAR; PG8_SCHED;
            PG8_LDA(At, 0, 1); PG8_STAGE(PG8_SB(0, 0), b2, voffB); PG8_STAGE(PG8_SB(0, 1), b2 + hstepB, voffB); PG8_STAGE(PG8_SA(0, 0), a2, voffA);
            PG8_WAIT_V(8); PG8_WAIT_L(0); PG8_BAR; PG8_MMA(1, 0, At, B0); PG8_MMA(1, 1, At, B1); PG8_BAR; PG8_SCHED;
            PG8_LDB(B0, 1, 0); PG8_LDB(B1, 1, 1); PG8_SCHED; PG8_LDA(At, 1, 0); PG8_STAGE(PG8_SA(0, 1), a2 + hstepA, voffA);
            PG8_WAIT_V(8); PG8_WAIT_L(0); PG8_BAR; PG8_MMA(0, 0, At, B0); PG8_MMA(0, 1, At, B1); PG8_BAR; PG8_SCHED;
            PG8_LDA(At, 1, 1); PG8_STAGE(PG8_SB(1, 0), b3, voffB); PG8_STAGE(PG8_SB(1, 1), b3 + hstepB, voffB); PG8_STAGE(PG8_SA(1, 0), a3, voffA);
            PG8_WAIT_V(8); PG8_WAIT_L(0); PG8_BAR; PG8_MMA(1, 0, At, B0); PG8_MMA(1, 1, At, B1); PG8_BAR; PG8_SCHED;
        }
        if (wr == 0) PG8_BAR;
        E(acc, cur, wr, wc, fr, fq);
        if (!has_next) break;
#pragma unroll
        for (int a = 0; a < 2; ++a)
#pragma unroll
            for (int b = 0; b < 2; ++b)
#pragma unroll
                for (int m = 0; m < 4; ++m)
#pragma unroll
                    for (int n = 0; n < 2; ++n) acc[a][b][m][n] = (f32x4){0.f, 0.f, 0.f, 0.f};
        cur = nxt; cA = nA; cB = nB; ++ui;
        if (wr == 1) PG8_BAR;
    }
    PG8_WAIT_V(0);
    PG8_BAR;
#undef PG8_SA
#undef PG8_SB
#undef PG8_STAGE
#undef PG8_LDA
#undef PG8_LDB
#undef PG8_MMA
#undef PG8_WAIT_V
#undef PG8_WAIT_L
#undef PG8_BAR
#undef PG8_SCHED
}
}

struct SchedStd {
    pg8::StaticOrder so; const char* A; const char* B; bf16_t* C; size_t a_tile, b_tile; int ldc, ccols, nt;
    __device__ __forceinline__ bool next(int i, pg8::Unit& u) const {
        pg8::PN p; if (!so.next(i, p)) return false;
        u.A = A + (size_t)p.pm * a_tile; u.B = B + (size_t)p.pn * b_tile; u.C = C + (size_t)p.pm * 256 * ldc + (size_t)p.pn * ccols; u.C2 = nullptr; u.nt = nt; u.aux = p.pn * 256; return true; }
};
struct SchedF1 {
    const char* D; const char* Z; bf16_t* Yt; int S, nunits, G, c;
    __device__ __forceinline__ bool next(int i, pg8::Unit& u) const {
        const int L = i * G + c; if (L >= nunits) return false;
        const int lg = (S == 4096) ? 4 : 3; const int pn = L & ((1 << lg) - 1); int t = L >> lg; const int pm = t & 1; t >>= 1; const int g = t & 3; const int b = t >> 2;
        u.A = D + (size_t)pm * 256 * 256 * 2; u.B = Z + ((size_t)(b * S + pn * 256) * NIN + 4608 + g * 256) * 2;
        u.C = Yt + (size_t)(b * 1024 + g * 256) * (2 * S) + (size_t)pm * S + pn * 256; u.C2 = nullptr; u.nt = 4; u.aux = 0; return true; }
};
struct SchedF2 {
    const char* DS; const char* Yt; bf16_t* AFM; int S, nunits, G, c;
    __device__ __forceinline__ bool next(int i, pg8::Unit& u) const {
        const int L = i * G + c; if (L >= nunits) return false;
        const int lg = (S == 4096) ? 4 : 3; const int pn = L & 3; const int t = L >> 2; const int pm = t & ((1 << lg) - 1); const int b = t >> lg;
        u.A = DS + (size_t)pm * 256 * S * 2; u.B = Yt + (size_t)(b * 1024 + pn * 256) * S * 2;
        u.C = AFM + (size_t)(b * S + pm * 256) * NAFM + 512 + pn * 256; u.C2 = nullptr; u.nt = S >> 6; u.aux = 0; return true; }
};
struct SchedP {
    pg8::StaticOrder so; const char* AFM; const char* WP; const bf16_t* Gc; bf16_t* Mg;
    __device__ __forceinline__ bool next(int i, pg8::Unit& u) const {
        const int j = i / 3, b = i - 3 * j; pg8::PN p; if (!so.next(j, p)) return false;
        const int koff = (b == 0) ? 0 : (b == 1 ? 512 : 1536);
        u.A = AFM + ((size_t)p.pm * 256 * NAFM + koff) * 2; u.B = WP + ((size_t)p.pn * 256 * NAFM + koff) * 2;
        u.C = Mg + (size_t)p.pm * 256 * DM + p.pn * 256; u.C2 = Gc + (size_t)p.pm * 256 * NGT + b * 2048 + p.pn * 256; u.nt = (b == 0) ? 8 : 16; u.aux = b + 4 * (b * 2048 + p.pn * 256); return true; }
};

template <bool XIN_BF16, bool XOUT_BF16>
__device__ __forceinline__ void row_op(const bf16_t* y, const void* xin_, void* xout_, bf16_t* xn, const float* g_post, const float* g_pre, float cres, int lane) {
    float v[32];
    if (XIN_BF16) { const bf16_t* xin = (const bf16_t*)xin_;
#pragma unroll
        for (int j = 0; j < 4; ++j) { const u32x4 w = *(const u32x4*)(xin + j * 512 + lane * 8);
            v[j * 8 + 0] = bf_lo(w.x); v[j * 8 + 1] = bf_hi(w.x); v[j * 8 + 2] = bf_lo(w.y); v[j * 8 + 3] = bf_hi(w.y);
            v[j * 8 + 4] = bf_lo(w.z); v[j * 8 + 5] = bf_hi(w.z); v[j * 8 + 6] = bf_lo(w.w); v[j * 8 + 7] = bf_hi(w.w); }
    } else { const float* xin = (const float*)xin_;
#pragma unroll
    for (int j = 0; j < 4; ++j) { const int e0 = j * 512 + lane * 8; const f32x4 a = *(const f32x4*)(xin + e0), b = *(const f32x4*)(xin + e0 + 4);
#pragma unroll
        for (int e = 0; e < 4; ++e) { v[j * 8 + e] = a[e]; v[j * 8 + 4 + e] = b[e]; } }
    }
    if (y) {
        float yv[32]; float ss = 0.f;
#pragma unroll
        for (int j = 0; j < 4; ++j) { const u32x4 w = *(const u32x4*)(y + j * 512 + lane * 8);
            yv[j * 8 + 0] = bf_lo(w.x); yv[j * 8 + 1] = bf_hi(w.x); yv[j * 8 + 2] = bf_lo(w.y); yv[j * 8 + 3] = bf_hi(w.y);
            yv[j * 8 + 4] = bf_lo(w.z); yv[j * 8 + 5] = bf_hi(w.z); yv[j * 8 + 6] = bf_lo(w.w); yv[j * 8 + 7] = bf_hi(w.w); }
#pragma unroll
        for (int i = 0; i < 32; ++i) ss += yv[i] * yv[i];
        ss = wave_sum(ss);
        const float rs = cres * (1.0f / sqrtf(ss * (1.0f / DM) + RMS_EPS));
#pragma unroll
        for (int j = 0; j < 4; ++j) { const int e0 = j * 512 + lane * 8; const f32x4 a = *(const f32x4*)(g_post + e0), b = *(const f32x4*)(g_post + e0 + 4);
#pragma unroll
            for (int e = 0; e < 4; ++e) { v[j * 8 + e] += yv[j * 8 + e] * rs * a[e]; v[j * 8 + 4 + e] += yv[j * 8 + 4 + e] * rs * b[e]; } }
    }
    if (xout_) {
        if (XOUT_BF16) { bf16_t* xout = (bf16_t*)xout_;
#pragma unroll
            for (int j = 0; j < 4; ++j) { u32x4 w; w.x = cvt_pk_bf16(v[j * 8 + 0], v[j * 8 + 1]); w.y = cvt_pk_bf16(v[j * 8 + 2], v[j * 8 + 3]); w.z = cvt_pk_bf16(v[j * 8 + 4], v[j * 8 + 5]); w.w = cvt_pk_bf16(v[j * 8 + 6], v[j * 8 + 7]);
                *(u32x4*)(xout + j * 512 + lane * 8) = w; }
        } else { float* xout = (float*)xout_;
#pragma unroll
        for (int j = 0; j < 4; ++j) { const int e0 = j * 512 + lane * 8;
            *(f32x4*)(xout + e0) = (f32x4){v[j * 8 + 0], v[j * 8 + 1], v[j * 8 + 2], v[j * 8 + 3]};
            *(f32x4*)(xout + e0 + 4) = (f32x4){v[j * 8 + 4], v[j * 8 + 5], v[j * 8 + 6], v[j * 8 + 7]}; }
        }
    }
    if (xn) {
        float ss = 0.f;
#pragma unroll
        for (int i = 0; i < 32; ++i) ss += v[i] * v[i];
        ss = wave_sum(ss);
        const float rs = 1.0f / sqrtf(ss * (1.0f / DM) + RMS_EPS);
#pragma unroll
        for (int j = 0; j < 4; ++j) { const int e0 = j * 512 + lane * 8; const f32x4 a = *(const f32x4*)(g_pre + e0), b = *(const f32x4*)(g_pre + e0 + 4);
            u32x4 w; w.x = cvt_pk_bf16(v[j * 8 + 0] * rs * a[0], v[j * 8 + 1] * rs * a[1]); w.y = cvt_pk_bf16(v[j * 8 + 2] * rs * a[2], v[j * 8 + 3] * rs * a[3]);
            w.z = cvt_pk_bf16(v[j * 8 + 4] * rs * b[0], v[j * 8 + 5] * rs * b[1]); w.w = cvt_pk_bf16(v[j * 8 + 6] * rs * b[2], v[j * 8 + 7] * rs * b[3]);
            *(u32x4*)(xn + e0) = w; }
    }
}

__device__ __forceinline__ void transpose_item(const float* W, int N, bf16_t* WT, int ldk, int koff, int row_off, int k0, int n0, LAS float* scr, int lane) {
#pragma unroll 16
    for (int i = 0; i < 64; ++i) scr[i * 65 + lane] = W[(size_t)(k0 + i) * N + n0 + lane];
    asm volatile("s_waitcnt lgkmcnt(0)" ::: "memory");
    const int c = lane & 7;
#pragma unroll
    for (int j = 0; j < 8; ++j) { const int n = (lane >> 3) + 8 * j; const LAS float* s = scr + (8 * c) * 65 + n;
        u32x4 o; o.x = cvt_pk_bf16(s[0 * 65], s[1 * 65]); o.y = cvt_pk_bf16(s[2 * 65], s[3 * 65]); o.z = cvt_pk_bf16(s[4 * 65], s[5 * 65]); o.w = cvt_pk_bf16(s[6 * 65], s[7 * 65]);
        *(u32x4*)(WT + (size_t)(row_off + n) * ldk + koff + k0 + 8 * c) = o; }
    asm volatile("s_waitcnt lgkmcnt(0)" ::: "memory");
}
__device__ __forceinline__ void convert_weight(const float* W, int K, int N, bf16_t* WT, int ldk, int koff, bool swiglu_perm, LAS float* scr, int gw, int ngw, int lane) {
    const int nblk = N / 64, nitems = (K / 64) * nblk;
    for (int it = gw; it < nitems; it += ngw) {
        const int kb = it / nblk, nb = it - kb * nblk, n0 = nb * 64;
        int row_off = n0;
        if (swiglu_perm) { const int half = (n0 >= DFF) ? 1 : 0; const int n1 = n0 - half * DFF; row_off = (n1 >> 7) * 256 + half * 128 + (n1 & 127); }
        transpose_item(W, N, WT, ldk, koff, row_off, kb * 64, n0, scr, lane);
    }
}

__device__ __forceinline__ int crow(int r, int hi) { return (r & 3) + 8 * (r >> 2) + 4 * hi; }
__device__ __forceinline__ bf16x8 pack8(const f32x16& s, int b) {
    u32x4 w; w.x = cvt_pk_bf16(s[b + 0], s[b + 1]); w.y = cvt_pk_bf16(s[b + 2], s[b + 3]); w.z = cvt_pk_bf16(s[b + 4], s[b + 5]); w.w = cvt_pk_bf16(s[b + 6], s[b + 7]);
    return __builtin_bit_cast(bf16x8, w);
}
__device__ __forceinline__ void dil_attn_unit(bf16_t* z, float* lse, const LAS float* biasL, int S, int unit, int lane) {
    const int h12 = unit >> 9, w = unit & 511;
    const int g = h12 >> 2, sh = 2 * g, L = S >> sh;
    const int spb = S >> 5; const int b = w / spb, v = w - b * spb; const int nlb = L >> 5; const int r = v / nlb, lb = v - r * nlb; const int l0 = lb * 32;
    const int q = lane & 31, hi = lane >> 5; const int lq = l0 + q;
    const size_t seqbase = (size_t)b * S;
    bf16_t* qrow = z + (seqbase + ((size_t)lq << sh) + r) * NIN + h12 * 128;
    bf16x8 qf[8];
#pragma unroll
    for (int ks = 0; ks < 8; ++ks) qf[ks] = *(const bf16x8*)(qrow + ks * 16 + hi * 8);
    f32x16 o[4];
#pragma unroll
    for (int dt = 0; dt < 4; ++dt)
#pragma unroll
        for (int i = 0; i < 16; ++i) o[dt][i] = 0.f;
    float m = -1e30f, lsum = 0.f;
    const float sc = 0.08838834764831845f * LOG2E;
    const LAS float* bl = biasL + h12 * 132 + 64;
    for (int kt = 0; kt < 5; ++kt) {
        const int kl0 = l0 - 64 + kt * 32;
        if (kl0 + 31 < 0 || kl0 >= L) continue;
        int kl = kl0 + q; kl = kl < 0 ? 0 : (kl > L - 1 ? L - 1 : kl);
        const bf16_t* kp = z + (seqbase + ((size_t)kl << sh) + r) * NIN + 1536 + h12 * 128 + hi * 8;
        f32x16 s;
#pragma unroll
        for (int i = 0; i < 16; ++i) s[i] = 0.f;
#pragma unroll
        for (int ks = 0; ks < 8; ++ks) { const bf16x8 kf = *(const bf16x8*)(kp + ks * 16); s = __builtin_amdgcn_mfma_f32_32x32x16_bf16(kf, qf[ks], s, 0, 0, 0); }
        float mx = -1e30f;
#pragma unroll
        for (int i = 0; i < 16; ++i) { const int lk = kl0 + crow(i, hi); const int dl = lk - lq; const bool valid = (dl >= -64) && (dl <= 64) && (lk >= 0) && (lk < L);
            const int di = dl < -64 ? -64 : (dl > 64 ? 64 : dl);
            const float vv = valid ? (s[i] * sc + bl[di]) : -1e30f; s[i] = vv; mx = fmaxf(mx, vv); }
        mx = fmaxf(mx, __shfl_xor(mx, 32));
        const float mn = fmaxf(m, mx); const float f = __builtin_amdgcn_exp2f(m - mn); m = mn;
        float ps = 0.f;
#pragma unroll
        for (int i = 0; i < 16; ++i) { const float p = __builtin_amdgcn_exp2f(s[i] - mn); s[i] = p; ps += p; }
        lsum = lsum * f + ps;
#pragma unroll
        for (int dt = 0; dt < 4; ++dt)
#pragma unroll
            for (int i = 0; i < 16; ++i) o[dt][i] *= f;
        const bf16x8 pa0 = pack8(s, 0), pa1 = pack8(s, 8);
#pragma unroll
        for (int s_ = 0; s_ < 2; ++s_) {
            u32x2 vv[8];
#pragma unroll
            for (int i = 0; i < 8; ++i) { int lk = kl0 + crow(8 * s_ + i, hi); lk = lk < 0 ? 0 : (lk > L - 1 ? L - 1 : lk);
                vv[i] = *(const u32x2*)(z + (seqbase + ((size_t)lk << sh) + r) * NIN + 3072 + h12 * 128 + 4 * q); }
#pragma unroll
            for (int dt = 0; dt < 4; ++dt) { u32x4 w;
                const unsigned sel = (dt & 1) ? 0x07060302u : 0x05040100u;
                if (dt < 2) { w.x = __builtin_amdgcn_perm(vv[1].x, vv[0].x, sel); w.y = __builtin_amdgcn_perm(vv[3].x, vv[2].x, sel); w.z = __builtin_amdgcn_perm(vv[5].x, vv[4].x, sel); w.w = __builtin_amdgcn_perm(vv[7].x, vv[6].x, sel); }
                else        { w.x = __builtin_amdgcn_perm(vv[1].y, vv[0].y, sel); w.y = __builtin_amdgcn_perm(vv[3].y, vv[2].y, sel); w.z = __builtin_amdgcn_perm(vv[5].y, vv[4].y, sel); w.w = __builtin_amdgcn_perm(vv[7].y, vv[6].y, sel); }
                o[dt] = __builtin_amdgcn_mfma_f32_32x32x16_bf16(__builtin_bit_cast(bf16x8, w), s_ ? pa1 : pa0, o[dt], 0, 0, 0); }
        }
    }
    lsum += __shfl_xor(lsum, 32);
    const float inv = 1.0f / lsum;
#pragma unroll
    for (int rg = 0; rg < 4; ++rg) {
        u32x4 w0, w1;
        w0.x = cvt_pk_bf16(o[0][4 * rg + 0] * inv, o[1][4 * rg + 0] * inv); w0.y = cvt_pk_bf16(o[2][4 * rg + 0] * inv, o[3][4 * rg + 0] * inv);
        w0.z = cvt_pk_bf16(o[0][4 * rg + 1] * inv, o[1][4 * rg + 1] * inv); w0.w = cvt_pk_bf16(o[2][4 * rg + 1] * inv, o[3][4 * rg + 1] * inv);
        w1.x = cvt_pk_bf16(o[0][4 * rg + 2] * inv, o[1][4 * rg + 2] * inv); w1.y = cvt_pk_bf16(o[2][4 * rg + 2] * inv, o[3][4 * rg + 2] * inv);
        w1.z = cvt_pk_bf16(o[0][4 * rg + 3] * inv, o[1][4 * rg + 3] * inv); w1.w = cvt_pk_bf16(o[2][4 * rg + 3] * inv, o[3][4 * rg + 3] * inv);
        *(u32x4*)(qrow + 32 * rg + 16 * hi) = w0; *(u32x4*)(qrow + 32 * rg + 16 * hi + 8) = w1; }
    if (hi == 0) lse[(seqbase + ((size_t)lq << sh) + r) * 12 + h12] = m + log2f(lsum);
}
__device__ __forceinline__ void mem_attn_unit(const bf16_t* z, const bf16_t* KVb, bf16_t* afm, int unit, int lane) {
    const int h = unit >> 9, w = unit & 511;
    const int q = lane & 31, hi = lane >> 5;
    const bf16_t* qp = z + (size_t)(w * 32 + q) * NIN + 5632 + h * 256 + hi * 8;
    f32x16 o[8];
#pragma unroll
    for (int dt = 0; dt < 8; ++dt)
#pragma unroll
        for (int i = 0; i < 16; ++i) o[dt][i] = 0.f;
    float m = -1e30f, lsum = 0.f;
    const float sc = 0.0625f * LOG2E;
    for (int kt = 0; kt < 8; ++kt) {
        const bf16_t* kp = KVb + (size_t)(kt * 32 + q) * 2048 + h * 256 + hi * 8;
        f32x16 s;
#pragma unroll
        for (int i = 0; i < 16; ++i) s[i] = 0.f;
#pragma unroll
        for (int ks = 0; ks < 16; ++ks) { const bf16x8 kf = *(const bf16x8*)(kp + ks * 16); const bf16x8 qf = *(const bf16x8*)(qp + ks * 16); s = __builtin_amdgcn_mfma_f32_32x32x16_bf16(kf, qf, s, 0, 0, 0); }
        float mx = -1e30f;
#pragma unroll
        for (int i = 0; i < 16; ++i) { s[i] *= sc; mx = fmaxf(mx, s[i]); }
        mx = fmaxf(mx, __shfl_xor(mx, 32));
        const float mn = fmaxf(m, mx); const float f = __builtin_amdgcn_exp2f(m - mn); m = mn;
        float ps = 0.f;
#pragma unroll
        for (int i = 0; i < 16; ++i) { const float p = __builtin_amdgcn_exp2f(s[i] - mn); s[i] = p; ps += p; }
        lsum = lsum * f + ps;
#pragma unroll
        for (int dt = 0; dt < 8; ++dt)
#pragma unroll
            for (int i = 0; i < 16; ++i) o[dt][i] *= f;
        const bf16x8 pa0 = pack8(s, 0), pa1 = pack8(s, 8);
#pragma unroll
        for (int s_ = 0; s_ < 2; ++s_) {
            const bf16_t* vb = KVb + (size_t)(kt * 32) * 2048 + 1024 + h * 256 + 8 * q;
            u32x4 vv[8];
#pragma unroll
            for (int i = 0; i < 8; ++i) vv[i] = *(const u32x4*)(vb + (size_t)crow(8 * s_ + i, hi) * 2048);
#pragma unroll
            for (int dt = 0; dt < 8; ++dt) { u32x4 w;
                const unsigned sel = (dt & 1) ? 0x07060302u : 0x05040100u; const int c = dt >> 1;
                w.x = __builtin_amdgcn_perm(vv[1][c], vv[0][c], sel); w.y = __builtin_amdgcn_perm(vv[3][c], vv[2][c], sel); w.z = __builtin_amdgcn_perm(vv[5][c], vv[4][c], sel); w.w = __builtin_amdgcn_perm(vv[7][c], vv[6][c], sel);
                o[dt] = __builtin_amdgcn_mfma_f32_32x32x16_bf16(__builtin_bit_cast(bf16x8, w), s_ ? pa1 : pa0, o[dt], 0, 0, 0); }
        }
    }
    lsum += __shfl_xor(lsum, 32);
    const float inv = 1.0f / lsum;
    bf16_t* op = afm + (size_t)(w * 32 + q) * NAFM + 1536 + h * 256;
#pragma unroll
    for (int r = 0; r < 16; ++r) {
        u32x4 w; w.x = cvt_pk_bf16(o[0][r] * inv, o[1][r] * inv); w.y = cvt_pk_bf16(o[2][r] * inv, o[3][r] * inv); w.z = cvt_pk_bf16(o[4][r] * inv, o[5][r] * inv); w.w = cvt_pk_bf16(o[6][r] * inv, o[7][r] * inv);
        *(u32x4*)(op + 8 * crow(r, hi)) = w; }
}

__device__ __forceinline__ int t5_bucket(int rel) {
    const int n = rel < 0 ? -rel : rel; const float nf = (float)(n < 1 ? 1 : n);
    int large = 8 + (int)(logf(nf / 8.0f) / 4.852030263919617f * 8.0f); large = large < 15 ? large : 15;
    return (rel > 0 ? 16 : 0) + (n < 8 ? n : large);
}


#define XB_TMO      128
#define XB_XCNT(j)  (256  + 64 * (j))
#define XB_XSUB(j)  (1280 + 64 * (j))
#define XB_XGEN(j)  (2304 + 64 * (j))
#define XB_TOP      3328
#define XB_TOPGEN   3392
#define XCD_BAR_WORDS 3456
#define XB_SPIN_CAP (1u << 22)
__device__ __forceinline__ unsigned xb_ld(unsigned* p)              { return __hip_atomic_load(p, __ATOMIC_RELAXED, __HIP_MEMORY_SCOPE_AGENT); }
__device__ __forceinline__ unsigned xb_add(unsigned* p, unsigned v) { return __hip_atomic_fetch_add(p, v, __ATOMIC_RELAXED, __HIP_MEMORY_SCOPE_AGENT); }
__device__ __forceinline__ unsigned xb_xcc_id() { return (unsigned)__builtin_amdgcn_s_getreg((3 << 11) | 20) & 0xFu; }
#define XB_SPIN(cond, bar) do { unsigned _sp = 0; while (cond) { __builtin_amdgcn_s_sleep(1); \
    if ((++_sp & 255u) == 0u) { if (xb_ld(&(bar)[XB_TMO])) break; if (_sp > XB_SPIN_CAP) { atomicAdd(&(bar)[XB_TMO], 1u); break; } } } } while (0)
struct XcdBarrier { unsigned* bar; unsigned x; volatile LAS unsigned* st; };
__device__ __forceinline__ XcdBarrier xcd_barrier_post(unsigned* bar, volatile LAS unsigned* st) {
    XcdBarrier b; b.bar = bar; b.x = xb_xcc_id(); b.st = st;
    if (threadIdx.x == 0) (void)xb_add(&bar[XB_XCNT(b.x)], 1u);
    return b;
}
__device__ __forceinline__ void xcd_barrier_complete(unsigned* bar, unsigned x, unsigned& nloc, unsigned& nx) {
    const unsigned G = gridDim.x * gridDim.y * gridDim.z;
    unsigned sum, cnt, mine, sp = 0u;
    for (;;) {
        sum = 0u; cnt = 0u; mine = 0u;
#pragma unroll
        for (unsigned j = 0; j < 16; ++j) { const unsigned c = xb_ld(&bar[XB_XCNT(j)]); sum += c; cnt += (c > 0u) ? 1u : 0u; mine = (j == x) ? c : mine; }
        if (sum == G) break;
        __builtin_amdgcn_s_sleep(1);
        if ((++sp & 255u) == 0u) { if (xb_ld(&bar[XB_TMO])) break; if (sp > XB_SPIN_CAP) { atomicAdd(&bar[XB_TMO], 1u); break; } }
    }
    nloc = mine > 0u ? mine : 1u; nx = cnt > 0u ? cnt : 1u;
}
__device__ __forceinline__ void xcd_barrier(const XcdBarrier& b) {
    asm volatile("s_waitcnt vmcnt(0)" ::: "memory");
    __syncthreads();
    if (threadIdx.x == 0) {
        unsigned* bar = b.bar;
        __builtin_amdgcn_s_waitcnt(0);
        unsigned nloc = b.st[0], nx = b.st[1];
        if (nloc == 0u) { xcd_barrier_complete(bar, b.x, nloc, nx); b.st[0] = nloc; b.st[1] = nx; }
        const unsigned old = xb_add(&bar[XB_XSUB(b.x)], 1u);
        const unsigned gen = old / nloc;
        if (old + 1u == (gen + 1u) * nloc) {
            __builtin_amdgcn_fence(__ATOMIC_RELEASE, "agent");
            asm volatile("s_waitcnt vmcnt(0)" ::: "memory");
            const unsigned og = xb_add(&bar[XB_TOP], 1u);
            const unsigned tg = og / nx;
            if (og + 1u == (tg + 1u) * nx) xb_add(&bar[XB_TOPGEN], 1u);
            else XB_SPIN(xb_ld(&bar[XB_TOPGEN]) == tg, bar);
            __builtin_amdgcn_fence(__ATOMIC_ACQUIRE, "agent");
            xb_add(&bar[XB_XGEN(b.x)], 1u);
            asm volatile("s_waitcnt vmcnt(0)" ::: "memory");
        } else {
            XB_SPIN(xb_ld(&bar[XB_XGEN(b.x)]) == gen, bar);
            __builtin_amdgcn_fence(__ATOMIC_ACQUIRE, "agent");
            asm volatile("s_waitcnt vmcnt(0)" ::: "memory");
        }
    }
    __syncthreads();
}

struct Args { const float* in[24]; float* out; unsigned char* ws; int ph_lo, ph_hi, coop, pad; };
constexpr int N_PHASES = 28;

__global__ void __launch_bounds__(512, 2) mk_fwd(Args args) {
    extern __shared__ __attribute__((aligned(16))) unsigned char lds_raw[];
    LAS unsigned char* lds = (LAS unsigned char*)lds_raw;
    const int G = gridDim.x, bx = blockIdx.x;
    unsigned char* ws = args.ws;
    float* out = args.out;
    bf16_t* XN = (bf16_t*)(ws + WS_XN); bf16_t* Hb = (bf16_t*)(ws + WS_H);
    bf16_t* ZG = (bf16_t*)(ws + WS_ZG); bf16_t* GG = (bf16_t*)(ws + WS_GG); bf16_t* AFM = (bf16_t*)(ws + WS_AFM); bf16_t* YT = (bf16_t*)(ws + WS_YT); float* LSE = (float*)(ws + WS_LSE);
    bf16_t* DS2 = (bf16_t*)(ws + WS_DS2); bf16_t* DS4 = (bf16_t*)(ws + WS_DS4); bf16_t* D256 = (bf16_t*)(ws + WS_D256);
    bf16_t* MEMN = (bf16_t*)(ws + WS_MEMN); bf16_t* KV = (bf16_t*)(ws + WS_KV); bf16_t* YF = (bf16_t*)(ws + WS_YF);
#if MK_COOP
    cg::grid_group grid = cg::this_grid();
    volatile LAS unsigned* xst = (volatile LAS unsigned*)(lds + 139264 + 64);
    if (threadIdx.x < 2) xst[threadIdx.x] = 0u;
    __syncthreads();
    const XcdBarrier xbar = xcd_barrier_post((unsigned*)ws, xst);
#endif

#ifndef PROBE_MASK
#define PROBE_MASK 0u
#endif
    for (int pi = args.ph_lo; pi < args.ph_hi; ++pi) {
        int ph = 0; { int acc_ = 0; for (int p_ = 0; p_ < N_PHASES; ++p_) { const int w_ = 1 + (int)((PROBE_MASK >> p_) & 1u); if (pi >= acc_ && pi < acc_ + w_) ph = p_; acc_ += w_; } }
        int tid = threadIdx.x; asm volatile("" : "+v"(tid));
        const int lane = tid & 63, wave = __builtin_amdgcn_readfirstlane(tid >> 6);
        const int gw = bx * 8 + wave, ngw = G * 8;
        const bool mix = (ph >= 4 && ph < 25);
        const int chunk = mix ? (ph - 4) / 7 : 0, mk = mix ? (ph - 4) % 7 : -1;
        const int S = (chunk == 2) ? 4096 : 2048, nseq = (chunk == 2) ? 4 : 8;
        const size_t crow0 = (size_t)chunk * CH;

        if (ph == 0) {
            LAS float* scr = (LAS float*)(lds + wave * 17408);
            convert_weight(args.in[6], DM, 2 * DFF, (bf16_t*)(ws + WS_W1U), DM, 0, true, scr, gw, ngw, lane);
            convert_weight(args.in[7], DFF, DM, (bf16_t*)(ws + WS_W1D), DFF, 0, false, scr, gw, ngw, lane);
            convert_weight(args.in[11], DM, NIN, (bf16_t*)(ws + WS_WIN), DM, 0, false, scr, gw, ngw, lane);
            convert_weight(args.in[13], DM, NGT, (bf16_t*)(ws + WS_WG), DM, 0, false, scr, gw, ngw, lane);
            convert_weight(args.in[12], DM, DM, (bf16_t*)(ws + WS_WKV), DM, 0, false, scr, gw, ngw, lane);
            convert_weight(args.in[15], 512, DM, (bf16_t*)(ws + WS_WP), NAFM, 0, false, scr, gw, ngw, lane);
            convert_weight(args.in[16], 1024, DM, (bf16_t*)(ws + WS_WP), NAFM, 512, false, scr, gw, ngw, lane);
            convert_weight(args.in[17], 1024, DM, (bf16_t*)(ws + WS_WP), NAFM, 1536, false, scr, gw, ngw, lane);
            convert_weight(args.in[18], DM, DM, (bf16_t*)(ws + WS_WO), DM, 0, false, scr, gw, ngw, lane);
            for (int row = gw; row < TT; row += ngw) {
                const float* xr = (row < TP) ? args.in[0] + (size_t)row * DM : args.in[1] + (size_t)(row - TP) * DM;
                row_op<false, false>(nullptr, xr, nullptr, XN + (size_t)row * DM, nullptr, args.in[5], 0.f, lane);
            }
        }
#ifndef DIS_G1
        if (ph == 1 || ph == 25) {
            SchedStd Sd; Sd.so.init(TT, 2 * DFF, G, bx); Sd.A = (const char*)XN; Sd.B = (const char*)(ws + WS_W1U); Sd.C = Hb;
            Sd.a_tile = (size_t)256 * DM * 2; Sd.b_tile = (size_t)256 * DM * 2; Sd.ldc = DFF; Sd.ccols = 128; Sd.nt = DM / 64;
            pg8::EpiSwiGLU E{DFF};
            pg8::gemm_phase<pg8::EpiSwiGLU, SchedStd>(lds, tid, DM, DM, Sd, E);
        }
#endif
#ifndef DIS_G2
        if (ph == 2 || ph == 26 || mk == 0 || mk == 5) {
            const int nrep = (mk == 0) ? (bx >= 128 ? 3 : 2) : 1;
            for (int rep = 0; rep < nrep; ++rep) {
                SchedStd Sd; int lda, ldb;
                if (ph == 2 || ph == 26) { Sd.so.init(TT, DM, G, bx); Sd.A = (const char*)Hb; Sd.B = (const char*)(ws + WS_W1D); Sd.C = XN; lda = DFF; ldb = DFF; Sd.ldc = DM; Sd.nt = DFF / 64; }
                else if (mk == 0 && rep == 0) { Sd.so.init(CH, NIN, G, bx); Sd.A = (const char*)(XN + crow0 * DM); Sd.B = (const char*)(ws + WS_WIN); Sd.C = ZG; lda = DM; ldb = DM; Sd.ldc = NIN; Sd.nt = DM / 64; }
                else if (mk == 0 && rep == 1) { Sd.so.init(CH, NGT, G, bx); Sd.A = (const char*)(XN + crow0 * DM); Sd.B = (const char*)(ws + WS_WG); Sd.C = GG; lda = DM; ldb = DM; Sd.ldc = NGT; Sd.nt = DM / 64; }
                else if (mk == 0) { const int mrow0 = (chunk == 2 ? 16 : chunk * 8) * 256; Sd.so.init(nseq * 256, DM, G - 128, bx - 128); Sd.A = (const char*)(MEMN + (size_t)mrow0 * DM); Sd.B = (const char*)(ws + WS_WKV); Sd.C = KV + (size_t)mrow0 * DM; lda = DM; ldb = DM; Sd.ldc = DM; Sd.nt = DM / 64; }
                else { Sd.so.init(CH, DM, G, bx); Sd.A = (const char*)YT; Sd.B = (const char*)(ws + WS_WO); Sd.C = ZG; lda = DM; ldb = DM; Sd.ldc = DM; Sd.nt = DM / 64; }
                Sd.a_tile = (size_t)256 * lda * 2; Sd.b_tile = (size_t)256 * ldb * 2; Sd.ccols = 256;
                pg8::EpiStore<0> E{Sd.ldc, nullptr};
                pg8::gemm_phase<pg8::EpiStore<0>, SchedStd>(lds, tid, lda, ldb, Sd, E);
            }
        }
#endif
#ifndef DIS_R3
        if (ph == 3) {
            for (int row = gw; row < TT; row += ngw) {
                const float* xr = (row < TP) ? args.in[0] + (size_t)row * DM : args.in[1] + (size_t)(row - TP) * DM;
                row_op<false, true>(XN + (size_t)row * DM, xr, out + (size_t)row * DM, XN + (size_t)row * DM, args.in[8], args.in[9], 0.5f, lane);
            }
            for (int row = gw; row < 5120; row += ngw) {
                const float* xr = (row < 4096) ? args.in[2] + (size_t)row * DM : args.in[3] + (size_t)(row - 4096) * DM;
                row_op<false, false>(nullptr, xr, nullptr, MEMN + (size_t)row * DM, nullptr, args.in[10], 0.f, lane);
            }
            { LAS float* scr = (LAS float*)(lds + wave * 17408);
              convert_weight(args.in[21], DM, 2 * DFF, (bf16_t*)(ws + WS_W1U), DM, 0, true, scr, gw, ngw, lane);
              convert_weight(args.in[22], DFF, DM, (bf16_t*)(ws + WS_W1D), DFF, 0, false, scr, gw, ngw, lane); }
            const int gt = bx * 512 + tid, ngt = G * 512;
            LAS float* ctab = (LAS float*)lds;
            for (int which = 0; which < 2; ++which) {
                const int SS = which ? 4096 : 2048; bf16_t* DS = which ? DS4 : DS2; const float scl = which ? 0.015625f : 0.022097086912079608f; const float inv = 2.0f / (float)SS;
                __syncthreads();
                for (int m_ = tid; m_ < SS; m_ += 512) ctab[m_] = cospif((float)m_ * inv) * scl;
                __syncthreads();
                const int per_row = SS / 8, total = SS * per_row, hS = SS >> 1;
                for (int idx = gt; idx < total; idx += ngt) { const int j = idx / per_row, k8 = (idx - j * per_row) * 8; float vv[8];
#pragma unroll
                    for (int e = 0; e < 8; ++e) { const int k = k8 + e; const int mm = (k <= hS) ? ((j * k) & (SS - 1)) : ((j * (k - hS) + (SS >> 2)) & (SS - 1)); vv[e] = ctab[mm]; }
                    u32x4 w; w.x = cvt_pk_bf16(vv[0], vv[1]); w.y = cvt_pk_bf16(vv[2], vv[3]); w.z = cvt_pk_bf16(vv[4], vv[5]); w.w = cvt_pk_bf16(vv[6], vv[7]);
                    *(u32x4*)(DS + (size_t)j * SS + k8) = w; }
            }
            __syncthreads();
            for (int idx = gt; idx < 512 * 256 / 8; idx += ngt) { const int mrow = idx / 32, c8 = (idx - mrow * 32) * 8; float vv[8];
#pragma unroll
                for (int e = 0; e < 8; ++e) { const int cc = c8 + e; const int mm = ((mrow & 255) * cc) & 255; const float x = (float)mm * (2.0f / 256.0f);
                    vv[e] = (mrow >= 256) ? sinpif(x) * 0.0625f : cospif(x) * 0.0625f; }
                u32x4 w; w.x = cvt_pk_bf16(vv[0], vv[1]); w.y = cvt_pk_bf16(vv[2], vv[3]); w.z = cvt_pk_bf16(vv[4], vv[5]); w.w = cvt_pk_bf16(vv[6], vv[7]);
                *(u32x4*)(D256 + (size_t)mrow * 256 + c8) = w; }
        }
#endif
#ifndef DIS_M1
        if (mk == 1) {
#ifndef DIS_F1
            { SchedF1 Sf{(const char*)D256, (const char*)ZG, YT, S, nseq * 4 * 2 * (S >> 8), G, bx};
              pg8::EpiStore<0> E{2 * S, nullptr};
              pg8::gemm_phase<pg8::EpiStore<0>, SchedF1>(lds, tid, 256, NIN, Sf, E); }
#endif
            LAS float* biasL = (LAS float*)lds;
#ifndef DIS_BIAS
            for (int idx = tid; idx < 12 * 129; idx += 512) { const int h12 = idx / 129, dd = idx - h12 * 129 - 64; const int g = h12 >> 2;
                biasL[h12 * 132 + dd + 64] = args.in[4][t5_bucket(dd * (1 << (2 * g))) * 12 + h12] * LOG2E; }
#endif
            __syncthreads();
#ifndef DIS_DIL
            for (int u = gw; u < 12 * 512; u += ngw) dil_attn_unit(ZG, LSE, biasL, S, u, lane);
#endif
#ifndef DIS_MEM
            for (int u = gw; u < 4 * 512; u += ngw) { const int w = u & 511; const int bglob = (chunk == 2 ? 16 : chunk * 8) + (w * 32) / S;
                mem_attn_unit(ZG, KV + (size_t)bglob * 256 * 2048, AFM, u, lane); }
#endif
            __syncthreads();
        }
#endif
#ifndef DIS_M2
        if (mk == 2) {
            {
                const int hS = S >> 1, per_row = S / 8, total = nseq * 1024 * per_row; const int gt = bx * 512 + tid, ngt = G * 512;
                for (int idx = gt; idx < total; idx += ngt) { const int row = idx / per_row, k8 = (idx - row * per_row) * 8; const bf16_t* yr = YT + (size_t)row * (2 * S); float vv[8];
#pragma unroll
                    for (int e = 0; e < 8; ++e) { const int kk = k8 + e;
                        if (kk == 0) vv[e] = bf_lo(yr[0]);
                        else if (kk < hS) vv[e] = bf_lo(yr[kk]) + bf_lo(yr[S - kk]);
                        else if (kk == hS) vv[e] = bf_lo(yr[hS]);
                        else { const int sidx = kk - hS; vv[e] = bf_lo(yr[S + sidx]) - bf_lo(yr[2 * S - sidx]); } }
                    u32x4 w; w.x = cvt_pk_bf16(vv[0], vv[1]); w.y = cvt_pk_bf16(vv[2], vv[3]); w.z = cvt_pk_bf16(vv[4], vv[5]); w.w = cvt_pk_bf16(vv[6], vv[7]);
                    *(u32x4*)(YF + (size_t)row * S + k8) = w; }
            }
            for (int t = gw; t < CH; t += ngw) { const int j = lane >> 4, e0 = (lane & 15) * 8;
                const float l0 = LSE[(size_t)t * 12 + j], l1 = LSE[(size_t)t * 12 + 4 + j], l2 = LSE[(size_t)t * 12 + 8 + j];
                const float mxl = fmaxf(l0, fmaxf(l1, l2)); float w0 = __builtin_amdgcn_exp2f(l0 - mxl), w1 = __builtin_amdgcn_exp2f(l1 - mxl), w2 = __builtin_amdgcn_exp2f(l2 - mxl);
                const float iw = 1.0f / (w0 + w1 + w2); w0 *= iw; w1 *= iw; w2 *= iw;
                const bf16_t* zr = ZG + (size_t)t * NIN + j * 128 + e0;
                const u32x4 a = *(const u32x4*)zr, b = *(const u32x4*)(zr + 512), c = *(const u32x4*)(zr + 1024);
                u32x4 o;
                o.x = cvt_pk_bf16(w0 * bf_lo(a.x) + w1 * bf_lo(b.x) + w2 * bf_lo(c.x), w0 * bf_hi(a.x) + w1 * bf_hi(b.x) + w2 * bf_hi(c.x));
                o.y = cvt_pk_bf16(w0 * bf_lo(a.y) + w1 * bf_lo(b.y) + w2 * bf_lo(c.y), w0 * bf_hi(a.y) + w1 * bf_hi(b.y) + w2 * bf_hi(c.y));
                o.z = cvt_pk_bf16(w0 * bf_lo(a.z) + w1 * bf_lo(b.z) + w2 * bf_lo(c.z), w0 * bf_hi(a.z) + w1 * bf_hi(b.z) + w2 * bf_hi(c.z));
                o.w = cvt_pk_bf16(w0 * bf_lo(a.w) + w1 * bf_lo(b.w) + w2 * bf_lo(c.w), w0 * bf_hi(a.w) + w1 * bf_hi(b.w) + w2 * bf_hi(c.w));
                *(u32x4*)(AFM + (size_t)t * NAFM + j * 128 + e0) = o; }
        }
#endif
        if (mk == 3) {
            SchedF2 Sf{(const char*)(chunk == 2 ? DS4 : DS2), (const char*)YF, AFM, S, nseq * (S >> 8) * 4, G, bx};
            pg8::EpiStore<0> E{NAFM, nullptr};
            pg8::gemm_phase<pg8::EpiStore<0>, SchedF2>(lds, tid, S, S, Sf, E);
        }
#ifndef DIS_M4
        if (mk == 4) {
            SchedP Sp; Sp.so.init(CH, DM, G, bx); Sp.AFM = (const char*)AFM; Sp.WP = (const char*)(ws + WS_WP); Sp.Gc = GG; Sp.Mg = YT;
            pg8::EpiGateRMW E{DM, args.in[14], NGT};
            pg8::gemm_phase<pg8::EpiGateRMW, SchedP>(lds, tid, NAFM, NAFM, Sp, E);
        }
#endif
#ifndef DIS_R6
        if (mk == 6 || ph == 27) {
            const int r0 = (ph == 27) ? 0 : (int)crow0, nr = (ph == 27) ? TT : CH;
            for (int row = gw; row < nr; row += ngw) { const size_t gr = (size_t)(r0 + row);
                const bf16_t* yr = (ph == 27) ? XN + gr * DM : ZG + (size_t)row * DM;
                if (ph == 27) row_op<true, false>(yr, out + gr * DM, out + gr * DM, nullptr, args.in[23], args.in[20], 0.5f, lane);
                else row_op<true, true>(yr, out + gr * DM, out + gr * DM, XN + gr * DM, args.in[19], args.in[20], 1.0f, lane); }
        }
#endif

#if MK_COOP
        if (pi + 1 < args.ph_hi) { if (pi == args.ph_lo) grid.sync(); else xcd_barrier(xbar); }
#endif
    }
}

extern "C" void kernel_launch(void* const* d_in, const int* in_sizes, int n_in, void* d_out, int out_size, void* d_ws, size_t ws_size, hipStream_t stream) {
    static int grid = 0;
    if (grid == 0) {
        if (n_in != 24 || out_size != TT * DM || ws_size < WS_END) { fprintf(stderr, "kernel_launch: unexpected shapes (n_in %d out %d ws %zu)\n", n_in, out_size, ws_size); grid = -1; return; }
        int dev = 0, cus = 0, per_cu = 0;
        hipGetDevice(&dev); hipDeviceGetAttribute(&cus, hipDeviceAttributeMultiprocessorCount, dev);
        if (hipFuncSetAttribute((const void*)mk_fwd, hipFuncAttributeMaxDynamicSharedMemorySize, LDS_BYTES) != hipSuccess) { fprintf(stderr, "kernel_launch: hipFuncSetAttribute failed\n"); grid = -1; return; }
        if (hipOccupancyMaxActiveBlocksPerMultiprocessor(&per_cu, (const void*)mk_fwd, 512, LDS_BYTES) != hipSuccess || per_cu < 1) { fprintf(stderr, "kernel_launch: occupancy query says %d\n", per_cu); per_cu = 1; }
        (void)hipGetLastError();
        grid = cus * 1;
    }
    if (grid < 0) return;
    Args a{};
    for (int i = 0; i < 24; ++i) a.in[i] = (const float*)d_in[i];
    a.out = (float*)d_out; a.ws = (unsigned char*)d_ws;
#if MK_COOP
    (void)hipMemsetAsync(d_ws, 0, 16384, stream);
    a.ph_lo = 0; a.ph_hi = N_PHASES + __builtin_popcount(PROBE_MASK); a.coop = 1;
    void* kargs[] = {&a};
    hipError_t e = hipLaunchCooperativeKernel((const void*)mk_fwd, dim3(grid), dim3(512), kargs, LDS_BYTES, stream);
    if (e != hipSuccess) fprintf(stderr, "cooperative launch failed: %s (grid %d)\n", hipGetErrorString(e), grid);
#else
    for (int ph = 0; ph < N_PHASES; ++ph) {
        a.ph_lo = ph; a.ph_hi = ph + 1; a.coop = 0;
        hipLaunchKernelGGL(mk_fwd, dim3(grid), dim3(512), LDS_BYTES, stream, a);
    }
#endif
}
```

```cpp
#include <hip/hip_runtime.h>
#include <hip/hip_cooperative_groups.h>
#include <cstdio>
#include <cstdint>
namespace cg = cooperative_groups;

#ifndef MK_COOP
#define MK_COOP 1
#endif

#define LAS __attribute__((address_space(3)))
typedef unsigned short bf16_t;
typedef short bf16x8 __attribute__((ext_vector_type(8)));
typedef float f32x4 __attribute__((ext_vector_type(4)));
typedef float f32x16 __attribute__((ext_vector_type(16)));
typedef unsigned u32x4 __attribute__((ext_vector_type(4)));
typedef unsigned u32x2 __attribute__((ext_vector_type(2)));

constexpr int TT = 49152, DM = 2048, DFF = 5632, NIN = 6656, NGT = 6144, CH = 16384, NAFM = 2560;
constexpr int TP = 32768;
constexpr float RMS_EPS = 1e-6f;
constexpr float LOG2E = 1.4426950408889634f;
constexpr size_t MiB = 1u << 20;
constexpr size_t WS_W1U = 1 * MiB;
constexpr size_t WS_W1D = WS_W1U + 44 * MiB;
constexpr size_t WS_YT = WS_W1D + 22 * MiB;
constexpr size_t WS_WIN = WS_YT + 66 * MiB;
constexpr size_t WS_WG = WS_WIN + 26 * MiB;
constexpr size_t WS_WKV = WS_WG + 24 * MiB;
constexpr size_t WS_WP = WS_WKV + 8 * MiB;
constexpr size_t WS_WO = WS_WP + 10 * MiB;
constexpr size_t WS_XN = WS_WO + 8 * MiB;
constexpr size_t WS_H = WS_XN + 192 * MiB;
constexpr size_t WS_ZG = WS_H;
constexpr size_t WS_GG = WS_ZG + 208 * MiB;
constexpr size_t WS_AFM = WS_GG + 192 * MiB;
constexpr size_t WS_LSE = WS_AFM + 80 * MiB;
constexpr size_t WS_MEMN = WS_LSE + 1 * MiB;
constexpr size_t WS_KV = WS_MEMN + 20 * MiB;
constexpr size_t WS_HEND = WS_H + 528 * MiB;
static_assert(WS_KV + 20 * MiB <= WS_HEND, "overlay map");
constexpr size_t WS_DS2 = WS_HEND;
constexpr size_t WS_DS4 = WS_DS2 + 8 * MiB;
constexpr size_t WS_D256 = WS_DS4 + 32 * MiB;
constexpr size_t WS_YF = WS_D256 + 1 * MiB;
constexpr size_t WS_END = WS_YF + 32 * MiB;
static_assert(WS_END <= 1024 * MiB, "workspace");

constexpr int LDS_BYTES = 140288;

__device__ __forceinline__ unsigned cvt_pk_bf16(float lo, float hi) { unsigned r; asm volatile("v_cvt_pk_bf16_f32 %0, %1, %2" : "=v"(r) : "v"(lo), "v"(hi)); return r; }
__device__ __forceinline__ float bf_lo(unsigned u) { return __uint_as_float(u << 16); }
__device__ __forceinline__ float bf_hi(unsigned u) { return __uint_as_float(u & 0xffff0000u); }
__device__ __forceinline__ float wave_sum(float v) {
#pragma unroll
    for (int o = 1; o < 64; o <<= 1) v += __shfl_xor(v, o);
    return v;
}
__device__ __forceinline__ float sigmoidf_(float x) { return __builtin_amdgcn_rcpf(1.0f + __builtin_amdgcn_exp2f(-x * LOG2E)); }

namespace pg8 {
constexpr int BM = 256, BK = 64, HALF = 128, HTB = HALF * BK * 2, STAGE_BYTES = 8 * HTB, NXCD = 8, WGM = 4;
__host__ __device__ __forceinline__ int lds_byte(int r, int c) { const int st = (r >> 4) * 2 + (c >> 5), rr = r & 15, cc = c & 31, ob = rr * 64 + cc * 2; return st * 1024 + (ob ^ (((ob >> 9) & 1) << 5)); }
__host__ __device__ __forceinline__ void stage_rc(int b, int& R, int& C) { const int st = b / 1024, sb = b % 1024, swz = sb ^ (((sb >> 9) & 1) << 5); R = (st >> 1) * 16 + swz / 64; C = (st & 1) * 32 + (swz % 64) / 2; }
__host__ __device__ __forceinline__ int perm32(int rho) { const int n = rho >> 4, i = rho & 15; return 8 * (i >> 2) + 4 * n + (i & 3); }

struct Unit { const char* A; const char* B; bf16_t* C; const bf16_t* C2; int nt; int aux; };
struct PN { int pm, pn; };
struct StaticOrder {
    int nM, nN, nwg, G, c;
    __device__ void init(int M, int N, int G_, int c_) { nM = M / BM; nN = N / BM; nwg = nM * nN; G = G_; c = c_; }
    __device__ bool next(int i, PN& u) const {
        const long L = (long)i * G + c; if (L >= nwg) return false;
        int wgid = (int)L; { const int q = nwg / NXCD, r = nwg % NXCD, xcd = wgid % NXCD, off = wgid / NXCD; wgid = (xcd < r ? xcd * (q + 1) : r * (q + 1) + (xcd - r) * q) + off; }
        const int nig = WGM * nN, gid = wgid / nig, fm = gid * WGM, gsz = (nM - fm) < WGM ? (nM - fm) : WGM;
        u.pm = fm + ((wgid % nig) % gsz); u.pn = (wgid % nig) / gsz; return true;
    }
};

template <int ACT> struct EpiStore {
    int ldc; const float* bias;
    __device__ __forceinline__ void operator()(const f32x4 (&acc)[2][2][4][2], const Unit& u, int wr, int wc, int fr, int fq) const {
        bf16_t* base = u.C + (size_t)(wr * 64 + fr) * ldc + wc * 32 + 8 * fq;
        f32x4 bv[2][2];
        if (ACT == 1) {
#pragma unroll
            for (int bj = 0; bj < 2; ++bj)
#pragma unroll
                for (int n = 0; n < 2; ++n) bv[bj][n] = *(const f32x4*)(bias + u.aux + bj * HALF + wc * 32 + 8 * fq + 4 * n);
        }
#pragma unroll
        for (int ai = 0; ai < 2; ++ai)
#pragma unroll
            for (int m = 0; m < 4; ++m) { bf16_t* rowp = base + (size_t)(ai * HALF + m * 16) * ldc;
#pragma unroll
                for (int bj = 0; bj < 2; ++bj) { f32x4 v0 = acc[ai][bj][m][0], v1 = acc[ai][bj][m][1];
                    if (ACT == 1) { v0 = v0 + bv[bj][0]; v1 = v1 + bv[bj][1];
#pragma unroll
                        for (int e = 0; e < 4; ++e) { v0[e] = sigmoidf_(v0[e]); v1[e] = sigmoidf_(v1[e]); } }
                    u32x4 w; w.x = cvt_pk_bf16(v0[0], v0[1]); w.y = cvt_pk_bf16(v0[2], v0[3]); w.z = cvt_pk_bf16(v1[0], v1[1]); w.w = cvt_pk_bf16(v1[2], v1[3]);
                    *(u32x4*)(rowp + bj * HALF) = w; } }
    }
};
struct EpiSwiGLU {
    int ldc;
    __device__ __forceinline__ void operator()(const f32x4 (&acc)[2][2][4][2], const Unit& u, int wr, int wc, int fr, int fq) const {
        bf16_t* base = u.C + (size_t)(wr * 64 + fr) * ldc + wc * 32 + 8 * fq;
#pragma unroll
        for (int ai = 0; ai < 2; ++ai)
#pragma unroll
            for (int m = 0; m < 4; ++m) { bf16_t* rowp = base + (size_t)(ai * HALF + m * 16) * ldc;
                f32x4 v0, v1;
#pragma unroll
                for (int e = 0; e < 4; ++e) { const float a0 = acc[ai][0][m][0][e], a1 = acc[ai][0][m][1][e];
                    v0[e] = a0 * sigmoidf_(a0) * acc[ai][1][m][0][e]; v1[e] = a1 * sigmoidf_(a1) * acc[ai][1][m][1][e]; }
                u32x4 w; w.x = cvt_pk_bf16(v0[0], v0[1]); w.y = cvt_pk_bf16(v0[2], v0[3]); w.z = cvt_pk_bf16(v1[0], v1[1]); w.w = cvt_pk_bf16(v1[2], v1[3]);
                *(u32x4*)rowp = w; }
    }
};
struct EpiGateRMW {
    int ldc; const float* bias; int ldg;
    __device__ __forceinline__ void operator()(const f32x4 (&acc)[2][2][4][2], const Unit& u, int wr, int wc, int fr, int fq) const {
        const size_t off0 = (size_t)(wr * 64 + fr) * ldc + wc * 32 + 8 * fq, goff0 = (size_t)(wr * 64 + fr) * ldg + wc * 32 + 8 * fq;
        f32x4 bv[2][2];
#pragma unroll
        for (int bj = 0; bj < 2; ++bj)
#pragma unroll
            for (int n = 0; n < 2; ++n) bv[bj][n] = *(const f32x4*)(bias + (u.aux >> 2) + bj * HALF + wc * 32 + 8 * fq + 4 * n);
#pragma unroll
        for (int ai = 0; ai < 2; ++ai)
#pragma unroll
            for (int m = 0; m < 4; ++m) { const size_t ro = off0 + (size_t)(ai * HALF + m * 16) * ldc, go = goff0 + (size_t)(ai * HALF + m * 16) * ldg;
#pragma unroll
                for (int bj = 0; bj < 2; ++bj) {
                    const u32x4 g = *(const u32x4*)(u.C2 + go + bj * HALF);
                    u32x4 o = (u32x4){0u, 0u, 0u, 0u}; if (u.aux & 3) o = *(const u32x4*)(u.C + ro + bj * HALF);
                    const f32x4 a0 = acc[ai][bj][m][0], a1 = acc[ai][bj][m][1];
                    const f32x4 b0 = bv[bj][0], b1 = bv[bj][1];
                    u32x4 w;
                    w.x = cvt_pk_bf16(bf_lo(o.x) + sigmoidf_(bf_lo(g.x) + b0[0]) * a0[0], bf_hi(o.x) + sigmoidf_(bf_hi(g.x) + b0[1]) * a0[1]);
                    w.y = cvt_pk_bf16(bf_lo(o.y) + sigmoidf_(bf_lo(g.y) + b0[2]) * a0[2], bf_hi(o.y) + sigmoidf_(bf_hi(g.y) + b0[3]) * a0[3]);
                    w.z = cvt_pk_bf16(bf_lo(o.z) + sigmoidf_(bf_lo(g.z) + b1[0]) * a1[0], bf_hi(o.z) + sigmoidf_(bf_hi(g.z) + b1[1]) * a1[1]);
                    w.w = cvt_pk_bf16(bf_lo(o.w) + sigmoidf_(bf_lo(g.w) + b1[2]) * a1[2], bf_hi(o.w) + sigmoidf_(bf_hi(g.w) + b1[3]) * a1[3]);
                    *(u32x4*)(u.C + ro + bj * HALF) = w; } }
    }
};

template <class Epi, class Sched>
__device__ __forceinline__ void gemm_phase(LAS unsigned char* lds, const int tid, const int lda, const int ldb, const Sched& S, const Epi& E) {
    const int wid = __builtin_amdgcn_readfirstlane(tid >> 6), lane = tid & 63, wr = wid >> 2, wc = wid & 3, fr = lane & 15, fq = lane >> 4;
    unsigned voffA[2], voffB[2];
#pragma unroll
    for (int i = 0; i < 2; ++i) { int R, C; stage_rc(tid * 16 + i * 8192, R, C); const int Rb = (R & ~31) + perm32(R & 31);
        voffA[i] = (unsigned)(R * lda + C) * 2u; voffB[i] = (unsigned)(Rb * ldb + C) * 2u; }
    const size_t kstep = (size_t)(BK * 2);
    const size_t hstepA = (size_t)HALF * lda * 2, hstepB = (size_t)HALF * ldb * 2;
    const unsigned ldsw = (unsigned)wid * 1024u;
    const int aoff = lds_byte(wr * 64 + fr, fq * 8), boff = lds_byte(wc * 32 + fr, fq * 8);
#define PG8_SA(b, h) (((b) * 2 + (h)) * HTB)
#define PG8_SB(b, h) ((4 + (b) * 2 + (h)) * HTB)
#define PG8_STAGE(bufoff, gbase, voff) do { _Pragma("unroll") for (int _i = 0; _i < 2; ++_i) \
        __builtin_amdgcn_global_load_lds((const unsigned*)((const char*)(gbase) + (voff)[_i]), (LAS unsigned*)(lds + (bufoff) + ldsw + _i * 8192), 16, 0, 0); } while (0)
#define PG8_LDA(dst, b, h) do { _Pragma("unroll") for (int m = 0; m < 4; ++m) _Pragma("unroll") for (int k = 0; k < 2; ++k) dst[m][k] = *(const LAS bf16x8*)(lds + PG8_SA(b, h) + aoff + m * 2048 + k * 1024); } while (0)
#define PG8_LDB(dst, b, h) do { _Pragma("unroll") for (int n = 0; n < 2; ++n) _Pragma("unroll") for (int k = 0; k < 2; ++k) dst[n][k] = *(const LAS bf16x8*)(lds + PG8_SB(b, h) + boff + n * 2048 + k * 1024); } while (0)
#define PG8_MMA(ai, bj, At, Bt) do { __builtin_amdgcn_s_setprio(1); _Pragma("unroll") for (int m = 0; m < 4; ++m) _Pragma("unroll") for (int n = 0; n < 2; ++n) _Pragma("unroll") for (int k = 0; k < 2; ++k) \
        acc[ai][bj][m][n] = __builtin_amdgcn_mfma_f32_16x16x32_bf16(Bt[n][k], At[m][k], acc[ai][bj][m][n], 0, 0, 0); __builtin_amdgcn_s_setprio(0); } while (0)
#define PG8_WAIT_V(n) asm volatile("s_waitcnt vmcnt(" #n ")" ::: "memory")
#define PG8_WAIT_L(n) asm volatile("s_waitcnt lgkmcnt(" #n ")" ::: "memory")
#define PG8_BAR __builtin_amdgcn_s_barrier()
#define PG8_SCHED __builtin_amdgcn_sched_barrier(0)
    Unit cur, nxt; int ui = 0;
    if (!S.next(0, cur)) return;
    f32x4 acc[2][2][4][2];
#pragma unroll
    for (int a = 0; a < 2; ++a)
#pragma unroll
        for (int b = 0; b < 2; ++b)
#pragma unroll
            for (int m = 0; m < 4; ++m)
#pragma unroll
                for (int n = 0; n < 2; ++n) acc[a][b][m][n] = (f32x4){0.f, 0.f, 0.f, 0.f};
    bf16x8 At[4][2], B0[2][2], B1[2][2];
    const char* cA = cur.A; const char* cB = cur.B;
    PG8_STAGE(PG8_SB(0, 0), cB, voffB); PG8_STAGE(PG8_SB(0, 1), cB + hstepB, voffB); PG8_STAGE(PG8_SA(0, 0), cA, voffA); PG8_STAGE(PG8_SA(0, 1), cA + hstepA, voffA);
    if (wr == 1) PG8_BAR;
    PG8_WAIT_V(2); PG8_BAR;
    PG8_STAGE(PG8_SB(1, 0), cB + kstep, voffB); PG8_STAGE(PG8_SA(1, 0), cA + kstep, voffA); PG8_STAGE(PG8_SB(1, 1), cB + hstepB + kstep, voffB);
    PG8_WAIT_V(6); PG8_BAR;
    for (;;) {
        const bool has_next = S.next(ui + 1, nxt);
        const char* nA = has_next ? nxt.A : cA; const char* nB = has_next ? nxt.B : cB;
        int nt = cur.nt; asm volatile("" : "+s"(nt));
        for (int t = 0; t < nt; t += 2) {
            const bool last = (t == nt - 2);
            const char* a1 = cA + (size_t)(t + 1) * kstep;
            const char* a2 = last ? nA : cA + (size_t)(t + 2) * kstep; const char* b2 = last ? nB : cB + (size_t)(t + 2) * kstep;
            const char* a3 = a2 + kstep; const char* b3 = b2 + kstep;
            PG8_LDB(B0, 0, 0); PG8_LDB(B1, 0, 1); PG8_SCHED; PG8_LDA(At, 0, 0); PG8_STAGE(PG8_SA(1, 1), a1 + hstepA, voffA);
            PG8_WAIT_V(8); PG8_WAIT_L(0); PG8_BAR; PG8_MMA(0, 0, At, B0); PG8_MMA(0, 1, At, B1); PG8_BAR; PG8_SCHED;
            PG8_LDA(At, 0, 1); PG8_STAGE(PG8_SB(0, 0), b2, voffB); PG8_STAGE(PG8_SB(0, 1), b2 + hstepB, voffB); PG8_STAGE(PG8_SA(0, 0), a2, voffA);
            PG8_WAIT_V(8); PG8_WAIT_L(0); PG8_BAR; PG8_MMA(1, 0, At, B0); PG8_MMA(1, 1, At, B1); PG8_BAR; PG8_SCHED;
            PG8_LDB(B0, 1, 0); PG8_LDB(B1, 1, 1); PG8_SCHED; PG8_LDA(At, 1, 0); PG8_STAGE(PG8_SA(0, 1), a2 + hstepA, voffA);
            PG8_WAIT_V(8); PG8_WAIT_L(0); PG8_BAR; PG8_MMA(0, 0, At, B0); PG8_MMA(0, 1, At, B1); PG8_BAR; PG8_SCHED;
            PG8_LDA(At, 1, 1); PG8_STAGE(PG8_SB(1, 0), b3, voffB); PG8_STAGE(PG8_SB(1, 1), b3 + hstepB, voffB); PG8_STAGE(PG8_SA(1, 0), a3, voffA);
            PG8_WAIT_V(8); PG8_WAIT_L(0); PG8_BAR; PG8_MMA(1, 0, At, B0); PG8_MMA(1, 1, At, B1); PG8_BAR; PG8_SCHED;
        }
        if (wr == 0) PG8_BAR;
        E(acc, cur, wr, wc, fr, fq);
        if (!has_next) break;
#pragma unroll
        for (int a = 0; a < 2; ++a)
#pragma unroll
            for (int b = 0; b < 2; ++b)
#pragma unroll
                for (int m = 0; m < 4; ++m)
#pragma unroll
                    for (int n = 0; n < 2; ++n) acc[a][b][m][n] = (f32x4){0.f, 0.f, 0.f, 0.f};
        cur = nxt; cA = nA; cB = nB; ++ui;
        if (wr == 1) PG8_BAR;
    }
    PG8_WAIT_V(0);
    PG8_BAR;
#undef PG8_SA
#undef PG8_SB
#undef PG8_STAGE
#undef PG8_LDA
#undef PG8_LDB
#undef PG8_MMA
#undef PG8_WAIT_V
#undef PG8_WAIT_L
#undef PG8_BAR
#undef PG8_SCHED
}
}

struct SchedStd {
    pg8::StaticOrder so; const char* A; const char* B; bf16_t* C; size_t a_tile, b_tile; int ldc, ccols, nt;
    __device__ __forceinline__ bool next(int i, pg8::Unit& u) const {
        pg8::PN p; if (!so.next(i, p)) return false;
        u.A = A + (size_t)p.pm * a_tile; u.B = B + (size_t)p.pn * b_tile; u.C = C + (size_t)p.pm * 256 * ldc + (size_t)p.pn * ccols; u.C2 = nullptr; u.nt = nt; u.aux = p.pn * 256; return true; }
};
struct SchedF1 {
    const char* D; const char* Z; bf16_t* Yt; int S, nunits, G, c;
    __device__ __forceinline__ bool next(int i, pg8::Unit& u) const {
        const int L = i * G + c; if (L >= nunits) return false;
        const int lg = (S == 4096) ? 4 : 3; const int pn = L & ((1 << lg) - 1); int t = L >> lg; const int pm = t & 1; t >>= 1; const int g = t & 3; const int b = t >> 2;
        u.A = D + (size_t)pm * 256 * 256 * 2; u.B = Z + ((size_t)(b * S + pn * 256) * NIN + 4608 + g * 256) * 2;
        u.C = Yt + (size_t)(b * 1024 + g * 256) * (2 * S) + (size_t)pm * S + pn * 256; u.C2 = nullptr; u.nt = 4; u.aux = 0; return true; }
};
struct SchedF2 {
    const char* DS; const char* Yt; bf16_t* AFM; int S, nunits, G, c;
    __device__ __forceinline__ bool next(int i, pg8::Unit& u) const {
        const int L = i * G + c; if (L >= nunits) return false;
        const int lg = (S == 4096) ? 4 : 3; const int pn = L & 3; const int t = L >> 2; const int pm = t & ((1 << lg) - 1); const int b = t >> lg;
        u.A = DS + (size_t)pm * 256 * S * 2; u.B = Yt + (size_t)(b * 1024 + pn * 256) * S * 2;
        u.C = AFM + (size_t)(b * S + pm * 256) * NAFM + 512 + pn * 256; u.C2 = nullptr; u.nt = S >> 6; u.aux = 0; return true; }
};
struct SchedP {
    pg8::StaticOrder so; const char* AFM; const char* WP; const bf16_t* Gc; bf16_t* Mg;
    __device__ __forceinline__ bool next(int i, pg8::Unit& u) const {
        const int j = i / 3, b = i - 3 * j; pg8::PN p; if (!so.next(j, p)) return false;
        const int koff = (b == 0) ? 0 : (b == 1 ? 512 : 1536);
        u.A = AFM + ((size_t)p.pm * 256 * NAFM + koff) * 2; u.B = WP + ((size_t)p.pn * 256 * NAFM + koff) * 2;
        u.C = Mg + (size_t)p.pm * 256 * DM + p.pn * 256; u.C2 = Gc + (size_t)p.pm * 256 * NGT + b * 2048 + p.pn * 256; u.nt = (b == 0) ? 8 : 16; u.aux = b + 4 * (b * 2048 + p.pn * 256); return true; }
};

template <bool XIN_BF16, bool XOUT_BF16>
__device__ __forceinline__ void row_op(const bf16_t* y, const void* xin_, void* xout_, bf16_t* xn, const float* g_post, const float* g_pre, float cres, int lane) {
    float v[32];
    if (XIN_BF16) { const bf16_t* xin = (const bf16_t*)xin_;
#pragma unroll
        for (int j = 0; j < 4; ++j) { const u32x4 w = *(const u32x4*)(xin + j * 512 + lane * 8);
            v[j * 8 + 0] = bf_lo(w.x); v[j * 8 + 1] = bf_hi(w.x); v[j * 8 + 2] = bf_lo(w.y); v[j * 8 + 3] = bf_hi(w.y);
            v[j * 8 + 4] = bf_lo(w.z); v[j * 8 + 5] = bf_hi(w.z); v[j * 8 + 6] = bf_lo(w.w); v[j * 8 + 7] = bf_hi(w.w); }
    } else { const float* xin = (const float*)xin_;
#pragma unroll
    for (int j = 0; j < 4; ++j) { const int e0 = j * 512 + lane * 8; const f32x4 a = *(const f32x4*)(xin + e0), b = *(const f32x4*)(xin + e0 + 4);
#pragma unroll
        for (int e = 0; e < 4; ++e) { v[j * 8 + e] = a[e]; v[j * 8 + 4 + e] = b[e]; } }
    }
    if (y) {
        float yv[32]; float ss = 0.f;
#pragma unroll
        for (int j = 0; j < 4; ++j) { const u32x4 w = *(const u32x4*)(y + j * 512 + lane * 8);
            yv[j * 8 + 0] = bf_lo(w.x); yv[j * 8 + 1] = bf_hi(w.x); yv[j * 8 + 2] = bf_lo(w.y); yv[j * 8 + 3] = bf_hi(w.y);
            yv[j * 8 + 4] = bf_lo(w.z); yv[j * 8 + 5] = bf_hi(w.z); yv[j * 8 + 6] = bf_lo(w.w); yv[j * 8 + 7] = bf_hi(w.w); }
#pragma unroll
        for (int i = 0; i < 32; ++i) ss += yv[i] * yv[i];
        ss = wave_sum(ss);
        const float rs = cres * (1.0f / sqrtf(ss * (1.0f / DM) + RMS_EPS));
#pragma unroll
        for (int j = 0; j < 4; ++j) { const int e0 = j * 512 + lane * 8; const f32x4 a = *(const f32x4*)(g_post + e0), b = *(const f32x4*)(g_post + e0 + 4);
#pragma unroll
            for (int e = 0; e < 4; ++e) { v[j * 8 + e] += yv[j * 8 + e] * rs * a[e]; v[j * 8 + 4 + e] += yv[j * 8 + 4 + e] * rs * b[e]; } }
    }
    if (xout_) {
        if (XOUT_BF16) { bf16_t* xout = (bf16_t*)xout_;
#pragma unroll
            for (int j = 0; j < 4; ++j) { u32x4 w; w.x = cvt_pk_bf16(v[j * 8 + 0], v[j * 8 + 1]); w.y = cvt_pk_bf16(v[j * 8 + 2], v[j * 8 + 3]); w.z = cvt_pk_bf16(v[j * 8 + 4], v[j * 8 + 5]); w.w = cvt_pk_bf16(v[j * 8 + 6], v[j * 8 + 7]);
                *(u32x4*)(xout + j * 512 + lane * 8) = w; }
        } else { float* xout = (float*)xout_;
#pragma unroll
        for (int j = 0; j < 4; ++j) { const int e0 = j * 512 + lane * 8;
            *(f32x4*)(xout + e0) = (f32x4){v[j * 8 + 0], v[j * 8 + 1], v[j * 8 + 2], v[j * 8 + 3]};
            *(f32x4*)(xout + e0 + 4) = (f32x4){v[j * 8 + 4], v[j * 8 + 5], v[j * 8 + 6], v[j * 8 + 7]}; }
        }
    }
    if (xn) {
        float ss = 0.f;
#pragma unroll
        for (int i = 0; i < 32; ++i) ss += v[i] * v[i];
        ss = wave_sum(ss);
        const float rs = 1.0f / sqrtf(ss * (1.0f / DM) + RMS_EPS);
#pragma unroll
        for (int j = 0; j < 4; ++j) { const int e0 = j * 512 + lane * 8; const f32x4 a = *(const f32x4*)(g_pre + e0), b = *(const f32x4*)(g_pre + e0 + 4);
            u32x4 w; w.x = cvt_pk_bf16(v[j * 8 + 0] * rs * a[0], v[j * 8 + 1] * rs * a[1]); w.y = cvt_pk_bf16(v[j * 8 + 2] * rs * a[2], v[j * 8 + 3] * rs * a[3]);
            w.z = cvt_pk_bf16(v[j * 8 + 4] * rs * b[0], v[j * 8 + 5] * rs * b[1]); w.w = cvt_pk_bf16(v[j * 8 + 6] * rs * b[2], v[j * 8 + 7] * rs * b[3]);
            *(u32x4*)(xn + e0) = w; }
    }
}

__device__ __forceinline__ void transpose_item(const float* W, int N, bf16_t* WT, int ldk, int koff, int row_off, int k0, int n0, LAS float* scr, int lane) {
#pragma unroll 16
    for (int i = 0; i < 64; ++i) scr[i * 65 + lane] = W[(size_t)(k0 + i) * N + n0 + lane];
    asm volatile("s_waitcnt lgkmcnt(0)" ::: "memory");
    const int c = lane & 7;
#pragma unroll
    for (int j = 0; j < 8; ++j) { const int n = (lane >> 3) + 8 * j; const LAS float* s = scr + (8 * c) * 65 + n;
        u32x4 o; o.x = cvt_pk_bf16(s[0 * 65], s[1 * 65]); o.y = cvt_pk_bf16(s[2 * 65], s[3 * 65]); o.z = cvt_pk_bf16(s[4 * 65], s[5 * 65]); o.w = cvt_pk_bf16(s[6 * 65], s[7 * 65]);
        *(u32x4*)(WT + (size_t)(row_off + n) * ldk + koff + k0 + 8 * c) = o; }
    asm volatile("s_waitcnt lgkmcnt(0)" ::: "memory");
}
__device__ __forceinline__ void convert_weight(const float* W, int K, int N, bf16_t* WT, int ldk, int koff, bool swiglu_perm, LAS float* scr, int gw, int ngw, int lane) {
    const int nblk = N / 64, nitems = (K / 64) * nblk;
    for (int it = gw; it < nitems; it += ngw) {
        const int kb = it / nblk, nb = it - kb * nblk, n0 = nb * 64;
        int row_off = n0;
        if (swiglu_perm) { const int half = (n0 >= DFF) ? 1 : 0; const int n1 = n0 - half * DFF; row_off = (n1 >> 7) * 256 + half * 128 + (n1 & 127); }
        transpose_item(W, N, WT, ldk, koff, row_off, kb * 64, n0, scr, lane);
    }
}

__device__ __forceinline__ int crow(int r, int hi) { return (r & 3) + 8 * (r >> 2) + 4 * hi; }
__device__ __forceinline__ bf16x8 pack8(const f32x16& s, int b) {
    u32x4 w; w.x = cvt_pk_bf16(s[b + 0], s[b + 1]); w.y = cvt_pk_bf16(s[b + 2], s[b + 3]); w.z = cvt_pk_bf16(s[b + 4], s[b + 5]); w.w = cvt_pk_bf16(s[b + 6], s[b + 7]);
    return __builtin_bit_cast(bf16x8, w);
}
__device__ __forceinline__ void dil_attn_unit(bf16_t* z, float* lse, const LAS float* biasL, int S, int unit, int lane) {
    const int h12 = unit >> 9, w = unit & 511;
    const int g = h12 >> 2, sh = 2 * g, L = S >> sh;
    const int spb = S >> 5; const int b = w / spb, v = w - b * spb; const int nlb = L >> 5; const int r = v / nlb, lb = v - r * nlb; const int l0 = lb * 32;
    const int q = lane & 31, hi = lane >> 5; const int lq = l0 + q;
    const size_t seqbase = (size_t)b * S;
    bf16_t* qrow = z + (seqbase + ((size_t)lq << sh) + r) * NIN + h12 * 128;
    bf16x8 qf[8];
#pragma unroll
    for (int ks = 0; ks < 8; ++ks) qf[ks] = *(const bf16x8*)(qrow + ks * 16 + hi * 8);
    f32x16 o[4];
#pragma unroll
    for (int dt = 0; dt < 4; ++dt)
#pragma unroll
        for (int i = 0; i < 16; ++i) o[dt][i] = 0.f;
    float m = -1e30f, lsum = 0.f;
    const float sc = 0.08838834764831845f * LOG2E;
    const LAS float* bl = biasL + h12 * 132 + 64;
    const int kt_lo = (l0 < 64) ? (2 - (l0 >> 5)) : 0; int kt_hi = (L - l0 + 64) >> 5; kt_hi = kt_hi > 5 ? 5 : kt_hi;
    bf16x8 kfn[8];
    { int kl = l0 - 64 + kt_lo * 32 + q; kl = kl < 0 ? 0 : (kl > L - 1 ? L - 1 : kl);
      const bf16_t* kp = z + (seqbase + ((size_t)kl << sh) + r) * NIN + 1536 + h12 * 128 + hi * 8;
#pragma unroll
      for (int ks = 0; ks < 8; ++ks) kfn[ks] = *(const bf16x8*)(kp + ks * 16); }
    for (int kt = kt_lo; kt < kt_hi; ++kt) {
        const int kl0 = l0 - 64 + kt * 32;
        u32x2 vv[2][8];
#pragma unroll
        for (int s_ = 0; s_ < 2; ++s_)
#pragma unroll
            for (int i = 0; i < 8; ++i) { int lk = kl0 + crow(8 * s_ + i, hi); lk = lk < 0 ? 0 : (lk > L - 1 ? L - 1 : lk);
                vv[s_][i] = *(const u32x2*)(z + (seqbase + ((size_t)lk << sh) + r) * NIN + 3072 + h12 * 128 + 4 * q); }
        f32x16 s;
#pragma unroll
        for (int i = 0; i < 16; ++i) s[i] = 0.f;
#pragma unroll
        for (int ks = 0; ks < 8; ++ks) s = __builtin_amdgcn_mfma_f32_32x32x16_bf16(kfn[ks], qf[ks], s, 0, 0, 0);
        if (kt + 1 < kt_hi) {
            int kl = kl0 + 32 + q; kl = kl < 0 ? 0 : (kl > L - 1 ? L - 1 : kl);
            const bf16_t* kp = z + (seqbase + ((size_t)kl << sh) + r) * NIN + 1536 + h12 * 128 + hi * 8;
#pragma unroll
            for (int ks = 0; ks < 8; ++ks) kfn[ks] = *(const bf16x8*)(kp + ks * 16); }
        float mx = -1e30f;
#pragma unroll
        for (int i = 0; i < 16; ++i) { const int lk = kl0 + crow(i, hi); const int dl = lk - lq; const bool valid = (dl >= -64) && (dl <= 64) && (lk >= 0) && (lk < L);
            const int di = dl < -64 ? -64 : (dl > 64 ? 64 : dl);
            const float vvv = valid ? (s[i] * sc + bl[di]) : -1e30f; s[i] = vvv; mx = fmaxf(mx, vvv); }
        mx = fmaxf(mx, __shfl_xor(mx, 32));
        const float mn = fmaxf(m, mx); const float f = __builtin_amdgcn_exp2f(m - mn); m = mn;
        float ps = 0.f;
#pragma unroll
        for (int i = 0; i < 16; ++i) { const float p = __builtin_amdgcn_exp2f(s[i] - mn); s[i] = p; ps += p; }
        lsum = lsum * f + ps;
#pragma unroll
        for (int dt = 0; dt < 4; ++dt)
#pragma unroll
            for (int i = 0; i < 16; ++i) o[dt][i] *= f;
        const bf16x8 pa0 = pack8(s, 0), pa1 = pack8(s, 8);
#pragma unroll
        for (int s_ = 0; s_ < 2; ++s_) {
#pragma unroll
            for (int dt = 0; dt < 4; ++dt) { u32x4 w;
                const unsigned sel = (dt & 1) ? 0x07060302u : 0x05040100u;
                if (dt < 2) { w.x = __builtin_amdgcn_perm(vv[s_][1].x, vv[s_][0].x, sel); w.y = __builtin_amdgcn_perm(vv[s_][3].x, vv[s_][2].x, sel); w.z = __builtin_amdgcn_perm(vv[s_][5].x, vv[s_][4].x, sel); w.w = __builtin_amdgcn_perm(vv[s_][7].x, vv[s_][6].x, sel); }
                else        { w.x = __builtin_amdgcn_perm(vv[s_][1].y, vv[s_][0].y, sel); w.y = __builtin_amdgcn_perm(vv[s_][3].y, vv[s_][2].y, sel); w.z = __builtin_amdgcn_perm(vv[s_][5].y, vv[s_][4].y, sel); w.w = __builtin_amdgcn_perm(vv[s_][7].y, vv[s_][6].y, sel); }
                o[dt] = __builtin_amdgcn_mfma_f32_32x32x16_bf16(__builtin_bit_cast(bf16x8, w), s_ ? pa1 : pa0, o[dt], 0, 0, 0); }
        }
    }
    lsum += __shfl_xor(lsum, 32);
    const float inv = 1.0f / lsum;
#pragma unroll
    for (int rg = 0; rg < 4; ++rg) {
        u32x4 w0, w1;
        w0.x = cvt_pk_bf16(o[0][4 * rg + 0] * inv, o[1][4 * rg + 0] * inv); w0.y = cvt_pk_bf16(o[2][4 * rg + 0] * inv, o[3][4 * rg + 0] * inv);
        w0.z = cvt_pk_bf16(o[0][4 * rg + 1] * inv, o[1][4 * rg + 1] * inv); w0.w = cvt_pk_bf16(o[2][4 * rg + 1] * inv, o[3][4 * rg + 1] * inv);
        w1.x = cvt_pk_bf16(o[0][4 * rg + 2] * inv, o[1][4 * rg + 2] * inv); w1.y = cvt_pk_bf16(o[2][4 * rg + 2] * inv, o[3][4 * rg + 2] * inv);
        w1.z = cvt_pk_bf16(o[0][4 * rg + 3] * inv, o[1][4 * rg + 3] * inv); w1.w = cvt_pk_bf16(o[2][4 * rg + 3] * inv, o[3][4 * rg + 3] * inv);
        *(u32x4*)(qrow + 32 * rg + 16 * hi) = w0; *(u32x4*)(qrow + 32 * rg + 16 * hi + 8) = w1; }
    if (hi == 0) lse[(seqbase + ((size_t)lq << sh) + r) * 12 + h12] = m + log2f(lsum);
}
__device__ __forceinline__ void mem_attn_unit(const bf16_t* z, const bf16_t* KVb, bf16_t* afm, int unit, int lane) {
    const int h = unit >> 9, w = unit & 511;
    const int q = lane & 31, hi = lane >> 5;
    const bf16_t* qp = z + (size_t)(w * 32 + q) * NIN + 5632 + h * 256 + hi * 8;
    f32x16 o[8];
#pragma unroll
    for (int dt = 0; dt < 8; ++dt)
#pragma unroll
        for (int i = 0; i < 16; ++i) o[dt][i] = 0.f;
    float m = -1e30f, lsum = 0.f;
    const float sc = 0.0625f * LOG2E;
    for (int kt = 0; kt < 8; ++kt) {
        const bf16_t* kp = KVb + (size_t)(kt * 32 + q) * 2048 + h * 256 + hi * 8;
        const bf16_t* vb = KVb + (size_t)(kt * 32) * 2048 + 1024 + h * 256 + 8 * q;
        u32x4 vv0[8], vv1[8];
#pragma unroll
        for (int i = 0; i < 8; ++i) vv0[i] = *(const u32x4*)(vb + (size_t)crow(i, hi) * 2048);
        f32x16 s;
#pragma unroll
        for (int i = 0; i < 16; ++i) s[i] = 0.f;
#pragma unroll
        for (int ks = 0; ks < 16; ++ks) { const bf16x8 kf = *(const bf16x8*)(kp + ks * 16); const bf16x8 qf = *(const bf16x8*)(qp + ks * 16); s = __builtin_amdgcn_mfma_f32_32x32x16_bf16(kf, qf, s, 0, 0, 0); }
        float mx = -1e30f;
#pragma unroll
        for (int i = 0; i < 16; ++i) { s[i] *= sc; mx = fmaxf(mx, s[i]); }
        mx = fmaxf(mx, __shfl_xor(mx, 32));
        const float mn = fmaxf(m, mx); const float f = __builtin_amdgcn_exp2f(m - mn); m = mn;
        float ps = 0.f;
#pragma unroll
        for (int i = 0; i < 16; ++i) { const float p = __builtin_amdgcn_exp2f(s[i] - mn); s[i] = p; ps += p; }
        lsum = lsum * f + ps;
#pragma unroll
        for (int dt = 0; dt < 8; ++dt)
#pragma unroll
            for (int i = 0; i < 16; ++i) o[dt][i] *= f;
        const bf16x8 pa0 = pack8(s, 0), pa1 = pack8(s, 8);
#pragma unroll
        for (int i = 0; i < 8; ++i) vv1[i] = *(const u32x4*)(vb + (size_t)crow(8 + i, hi) * 2048);
#pragma unroll
        for (int dt = 0; dt < 8; ++dt) { u32x4 w;
            const unsigned sel = (dt & 1) ? 0x07060302u : 0x05040100u; const int c = dt >> 1;
            w.x = __builtin_amdgcn_perm(vv0[1][c], vv0[0][c], sel); w.y = __builtin_amdgcn_perm(vv0[3][c], vv0[2][c], sel); w.z = __builtin_amdgcn_perm(vv0[5][c], vv0[4][c], sel); w.w = __builtin_amdgcn_perm(vv0[7][c], vv0[6][c], sel);
            o[dt] = __builtin_amdgcn_mfma_f32_32x32x16_bf16(__builtin_bit_cast(bf16x8, w), pa0, o[dt], 0, 0, 0); }
#pragma unroll
        for (int dt = 0; dt < 8; ++dt) { u32x4 w;
            const unsigned sel = (dt & 1) ? 0x07060302u : 0x05040100u; const int c = dt >> 1;
            w.x = __builtin_amdgcn_perm(vv1[1][c], vv1[0][c], sel); w.y = __builtin_amdgcn_perm(vv1[3][c], vv1[2][c], sel); w.z = __builtin_amdgcn_perm(vv1[5][c], vv1[4][c], sel); w.w = __builtin_amdgcn_perm(vv1[7][c], vv1[6][c], sel);
            o[dt] = __builtin_amdgcn_mfma_f32_32x32x16_bf16(__builtin_bit_cast(bf16x8, w), pa1, o[dt], 0, 0, 0); }
    }
    lsum += __shfl_xor(lsum, 32);
    const float inv = 1.0f / lsum;
    bf16_t* op = afm + (size_t)(w * 32 + q) * NAFM + 1536 + h * 256;
#pragma unroll
    for (int r = 0; r < 16; ++r) {
        u32x4 w; w.x = cvt_pk_bf16(o[0][r] * inv, o[1][r] * inv); w.y = cvt_pk_bf16(o[2][r] * inv, o[3][r] * inv); w.z = cvt_pk_bf16(o[4][r] * inv, o[5][r] * inv); w.w = cvt_pk_bf16(o[6][r] * inv, o[7][r] * inv);
        *(u32x4*)(op + 8 * crow(r, hi)) = w; }
}

__device__ __forceinline__ int t5_bucket(int rel) {
    const int n = rel < 0 ? -rel : rel; const float nf = (float)(n < 1 ? 1 : n);
    int large = 8 + (int)(logf(nf / 8.0f) / 4.852030263919617f * 8.0f); large = large < 15 ? large : 15;
    return (rel > 0 ? 16 : 0) + (n < 8 ? n : large);
}


#define XB_TMO      128
#define XB_XCNT(j)  (256  + 64 * (j))
#define XB_XSUB(j)  (1280 + 64 * (j))
#define XB_XGEN(j)  (2304 + 64 * (j))
#define XB_TOP      3328
#define XB_TOPGEN   3392
#define XCD_BAR_WORDS 3456
#define XB_SPIN_CAP (1u << 22)
__device__ __forceinline__ unsigned xb_ld(unsigned* p)              { return __hip_atomic_load(p, __ATOMIC_RELAXED, __HIP_MEMORY_SCOPE_AGENT); }
__device__ __forceinline__ unsigned xb_add(unsigned* p, unsigned v) { return __hip_atomic_fetch_add(p, v, __ATOMIC_RELAXED, __HIP_MEMORY_SCOPE_AGENT); }
__device__ __forceinline__ unsigned xb_xcc_id() { return (unsigned)__builtin_amdgcn_s_getreg((3 << 11) | 20) & 0xFu; }
#define XB_SPIN(cond, bar) do { unsigned _sp = 0; while (cond) { __builtin_amdgcn_s_sleep(1); \
    if ((++_sp & 255u) == 0u) { if (xb_ld(&(bar)[XB_TMO])) break; if (_sp > XB_SPIN_CAP) { atomicAdd(&(bar)[XB_TMO], 1u); break; } } } } while (0)
struct XcdBarrier { unsigned* bar; unsigned x; volatile LAS unsigned* st; };
__device__ __forceinline__ XcdBarrier xcd_barrier_post(unsigned* bar, volatile LAS unsigned* st) {
    XcdBarrier b; b.bar = bar; b.x = xb_xcc_id(); b.st = st;
    if (threadIdx.x == 0) (void)xb_add(&bar[XB_XCNT(b.x)], 1u);
    return b;
}
__device__ __forceinline__ void xcd_barrier_complete(unsigned* bar, unsigned x, unsigned& nloc, unsigned& nx) {
    const unsigned G = gridDim.x * gridDim.y * gridDim.z;
    unsigned sum, cnt, mine, sp = 0u;
    for (;;) {
        sum = 0u; cnt = 0u; mine = 0u;
#pragma unroll
        for (unsigned j = 0; j < 16; ++j) { const unsigned c = xb_ld(&bar[XB_XCNT(j)]); sum += c; cnt += (c > 0u) ? 1u : 0u; mine = (j == x) ? c : mine; }
        if (sum == G) break;
        __builtin_amdgcn_s_sleep(1);
        if ((++sp & 255u) == 0u) { if (xb_ld(&bar[XB_TMO])) break; if (sp > XB_SPIN_CAP) { atomicAdd(&bar[XB_TMO], 1u); break; } }
    }
    nloc = mine > 0u ? mine : 1u; nx = cnt > 0u ? cnt : 1u;
}
__device__ __forceinline__ void xcd_barrier(const XcdBarrier& b) {
    asm volatile("s_waitcnt vmcnt(0)" ::: "memory");
    __syncthreads();
    if (threadIdx.x == 0) {
        unsigned* bar = b.bar;
        __builtin_amdgcn_s_waitcnt(0);
        unsigned nloc = b.st[0], nx = b.st[1];
        if (nloc == 0u) { xcd_barrier_complete(bar, b.x, nloc, nx); b.st[0] = nloc; b.st[1] = nx; }
        const unsigned old = xb_add(&bar[XB_XSUB(b.x)], 1u);
        const unsigned gen = old / nloc;
        if (old + 1u == (gen + 1u) * nloc) {
            __builtin_amdgcn_fence(__ATOMIC_RELEASE, "agent");
            asm volatile("s_waitcnt vmcnt(0)" ::: "memory");
            const unsigned og = xb_add(&bar[XB_TOP], 1u);
            const unsigned tg = og / nx;
            if (og + 1u == (tg + 1u) * nx) xb_add(&bar[XB_TOPGEN], 1u);
            else XB_SPIN(xb_ld(&bar[XB_TOPGEN]) == tg, bar);
            __builtin_amdgcn_fence(__ATOMIC_ACQUIRE, "agent");
            xb_add(&bar[XB_XGEN(b.x)], 1u);
            asm volatile("s_waitcnt vmcnt(0)" ::: "memory");
        } else {
            XB_SPIN(xb_ld(&bar[XB_XGEN(b.x)]) == gen, bar);
            __builtin_amdgcn_fence(__ATOMIC_ACQUIRE, "agent");
            asm volatile("s_waitcnt vmcnt(0)" ::: "memory");
        }
    }
    __syncthreads();
}

struct Args { const float* in[24]; float* out; unsigned char* ws; int ph_lo, ph_hi, coop, pad; };
constexpr int N_PHASES = 28;

__global__ void __launch_bounds__(512, 2) mk_fwd(Args args) {
    extern __shared__ __attribute__((aligned(16))) unsigned char lds_raw[];
    LAS unsigned char* lds = (LAS unsigned char*)lds_raw;
    const int G = gridDim.x, bx = blockIdx.x;
    unsigned char* ws = args.ws;
    float* out = args.out;
    bf16_t* XN = (bf16_t*)(ws + WS_XN); bf16_t* Hb = (bf16_t*)(ws + WS_H);
    bf16_t* ZG = (bf16_t*)(ws + WS_ZG); bf16_t* GG = (bf16_t*)(ws + WS_GG); bf16_t* AFM = (bf16_t*)(ws + WS_AFM); bf16_t* YT = (bf16_t*)(ws + WS_YT); float* LSE = (float*)(ws + WS_LSE);
    bf16_t* DS2 = (bf16_t*)(ws + WS_DS2); bf16_t* DS4 = (bf16_t*)(ws + WS_DS4); bf16_t* D256 = (bf16_t*)(ws + WS_D256);
    bf16_t* MEMN = (bf16_t*)(ws + WS_MEMN); bf16_t* KV = (bf16_t*)(ws + WS_KV); bf16_t* YF = (bf16_t*)(ws + WS_YF);
#if MK_COOP
    cg::grid_group grid = cg::this_grid();
    volatile LAS unsigned* xst = (volatile LAS unsigned*)(lds + 139264 + 64);
    if (threadIdx.x < 2) xst[threadIdx.x] = 0u;
    __syncthreads();
    const XcdBarrier xbar = xcd_barrier_post((unsigned*)ws, xst);
#endif

#ifndef PROBE_MASK
#define PROBE_MASK 0u
#endif
    for (int pi = args.ph_lo; pi < args.ph_hi; ++pi) {
        int ph = 0; { int acc_ = 0; for (int p_ = 0; p_ < N_PHASES; ++p_) { const int w_ = 1 + (int)((PROBE_MASK >> p_) & 1u); if (pi >= acc_ && pi < acc_ + w_) ph = p_; acc_ += w_; } }
        int tid = threadIdx.x; asm volatile("" : "+v"(tid));
        const int lane = tid & 63, wave = __builtin_amdgcn_readfirstlane(tid >> 6);
        const int gw = bx * 8 + wave, ngw = G * 8;
        const bool mix = (ph >= 4 && ph < 25);
        const int chunk = mix ? (ph - 4) / 7 : 0, mk = mix ? (ph - 4) % 7 : -1;
        const int S = (chunk == 2) ? 4096 : 2048, nseq = (chunk == 2) ? 4 : 8;
        const size_t crow0 = (size_t)chunk * CH;

        if (ph == 0) {
            LAS float* scr = (LAS float*)(lds + wave * 17408);
            convert_weight(args.in[6], DM, 2 * DFF, (bf16_t*)(ws + WS_W1U), DM, 0, true, scr, gw, ngw, lane);
            convert_weight(args.in[7], DFF, DM, (bf16_t*)(ws + WS_W1D), DFF, 0, false, scr, gw, ngw, lane);
            convert_weight(args.in[11], DM, NIN, (bf16_t*)(ws + WS_WIN), DM, 0, false, scr, gw, ngw, lane);
            convert_weight(args.in[13], DM, NGT, (bf16_t*)(ws + WS_WG), DM, 0, false, scr, gw, ngw, lane);
            convert_weight(args.in[12], DM, DM, (bf16_t*)(ws + WS_WKV), DM, 0, false, scr, gw, ngw, lane);
            convert_weight(args.in[15], 512, DM, (bf16_t*)(ws + WS_WP), NAFM, 0, false, scr, gw, ngw, lane);
            convert_weight(args.in[16], 1024, DM, (bf16_t*)(ws + WS_WP), NAFM, 512, false, scr, gw, ngw, lane);
            convert_weight(args.in[17], 1024, DM, (bf16_t*)(ws + WS_WP), NAFM, 1536, false, scr, gw, ngw, lane);
            convert_weight(args.in[18], DM, DM, (bf16_t*)(ws + WS_WO), DM, 0, false, scr, gw, ngw, lane);
            for (int row = gw; row < TT; row += ngw) {
                const float* xr = (row < TP) ? args.in[0] + (size_t)row * DM : args.in[1] + (size_t)(row - TP) * DM;
                row_op<false, false>(nullptr, xr, nullptr, XN + (size_t)row * DM, nullptr, args.in[5], 0.f, lane);
            }
        }
#ifndef DIS_G1
        if (ph == 1 || ph == 25) {
            SchedStd Sd; Sd.so.init(TT, 2 * DFF, G, bx); Sd.A = (const char*)XN; Sd.B = (const char*)(ws + WS_W1U); Sd.C = Hb;
            Sd.a_tile = (size_t)256 * DM * 2; Sd.b_tile = (size_t)256 * DM * 2; Sd.ldc = DFF; Sd.ccols = 128; Sd.nt = DM / 64;
            pg8::EpiSwiGLU E{DFF};
            pg8::gemm_phase<pg8::EpiSwiGLU, SchedStd>(lds, tid, DM, DM, Sd, E);
        }
#endif
#ifndef DIS_G2
        if (ph == 2 || ph == 26 || mk == 0 || mk == 5) {
            const int nrep = (mk == 0) ? (bx >= 128 ? 3 : 2) : 1;
            for (int rep = 0; rep < nrep; ++rep) {
                SchedStd Sd; int lda, ldb;
                if (ph == 2 || ph == 26) { Sd.so.init(TT, DM, G, bx); Sd.A = (const char*)Hb; Sd.B = (const char*)(ws + WS_W1D); Sd.C = XN; lda = DFF; ldb = DFF; Sd.ldc = DM; Sd.nt = DFF / 64; }
                else if (mk == 0 && rep == 0) { Sd.so.init(CH, NIN, G, bx); Sd.A = (const char*)(XN + crow0 * DM); Sd.B = (const char*)(ws + WS_WIN); Sd.C = ZG; lda = DM; ldb = DM; Sd.ldc = NIN; Sd.nt = DM / 64; }
                else if (mk == 0 && rep == 1) { Sd.so.init(CH, NGT, G, bx); Sd.A = (const char*)(XN + crow0 * DM); Sd.B = (const char*)(ws + WS_WG); Sd.C = GG; lda = DM; ldb = DM; Sd.ldc = NGT; Sd.nt = DM / 64; }
                else if (mk == 0) { const int mrow0 = (chunk == 2 ? 16 : chunk * 8) * 256; Sd.so.init(nseq * 256, DM, G - 128, bx - 128); Sd.A = (const char*)(MEMN + (size_t)mrow0 * DM); Sd.B = (const char*)(ws + WS_WKV); Sd.C = KV + (size_t)mrow0 * DM; lda = DM; ldb = DM; Sd.ldc = DM; Sd.nt = DM / 64; }
                else { Sd.so.init(CH, DM, G, bx); Sd.A = (const char*)YT; Sd.B = (const char*)(ws + WS_WO); Sd.C = ZG; lda = DM; ldb = DM; Sd.ldc = DM; Sd.nt = DM / 64; }
                Sd.a_tile = (size_t)256 * lda * 2; Sd.b_tile = (size_t)256 * ldb * 2; Sd.ccols = 256;
                pg8::EpiStore<0> E{Sd.ldc, nullptr};
                pg8::gemm_phase<pg8::EpiStore<0>, SchedStd>(lds, tid, lda, ldb, Sd, E);
            }
        }
#endif
#ifndef DIS_R3
        if (ph == 3) {
            for (int row = gw; row < TT; row += ngw) {
                const float* xr = (row < TP) ? args.in[0] + (size_t)row * DM : args.in[1] + (size_t)(row - TP) * DM;
                row_op<false, true>(XN + (size_t)row * DM, xr, out + (size_t)row * DM, XN + (size_t)row * DM, args.in[8], args.in[9], 0.5f, lane);
            }
            for (int row = gw; row < 5120; row += ngw) {
                const float* xr = (row < 4096) ? args.in[2] + (size_t)row * DM : args.in[3] + (size_t)(row - 4096) * DM;
                row_op<false, false>(nullptr, xr, nullptr, MEMN + (size_t)row * DM, nullptr, args.in[10], 0.f, lane);
            }
            { LAS float* scr = (LAS float*)(lds + wave * 17408);
              convert_weight(args.in[21], DM, 2 * DFF, (bf16_t*)(ws + WS_W1U), DM, 0, true, scr, gw, ngw, lane);
              convert_weight(args.in[22], DFF, DM, (bf16_t*)(ws + WS_W1D), DFF, 0, false, scr, gw, ngw, lane); }
            const int gt = bx * 512 + tid, ngt = G * 512;
            LAS float* ctab = (LAS float*)lds;
            for (int which = 0; which < 2; ++which) {
                const int SS = which ? 4096 : 2048; bf16_t* DS = which ? DS4 : DS2; const float scl = which ? 0.015625f : 0.022097086912079608f; const float inv = 2.0f / (float)SS;
                __syncthreads();
                for (int m_ = tid; m_ < SS; m_ += 512) ctab[m_] = cospif((float)m_ * inv) * scl;
                __syncthreads();
                const int per_row = SS / 8, total = SS * per_row, hS = SS >> 1;
                for (int idx = gt; idx < total; idx += ngt) { const int j = idx / per_row, k8 = (idx - j * per_row) * 8; float vv[8];
#pragma unroll
                    for (int e = 0; e < 8; ++e) { const int k = k8 + e; const int mm = (k <= hS) ? ((j * k) & (SS - 1)) : ((j * (k - hS) + (SS >> 2)) & (SS - 1)); vv[e] = ctab[mm]; }
                    u32x4 w; w.x = cvt_pk_bf16(vv[0], vv[1]); w.y = cvt_pk_bf16(vv[2], vv[3]); w.z = cvt_pk_bf16(vv[4], vv[5]); w.w = cvt_pk_bf16(vv[6], vv[7]);
                    *(u32x4*)(DS + (size_t)j * SS + k8) = w; }
            }
            __syncthreads();
            for (int idx = gt; idx < 512 * 256 / 8; idx += ngt) { const int mrow = idx / 32, c8 = (idx - mrow * 32) * 8; float vv[8];
#pragma unroll
                for (int e = 0; e < 8; ++e) { const int cc = c8 + e; const int mm = ((mrow & 255) * cc) & 255; const float x = (float)mm * (2.0f / 256.0f);
                    vv[e] = (mrow >= 256) ? sinpif(x) * 0.0625f : cospif(x) * 0.0625f; }
                u32x4 w; w.x = cvt_pk_bf16(vv[0], vv[1]); w.y = cvt_pk_bf16(vv[2], vv[3]); w.z = cvt_pk_bf16(vv[4], vv[5]); w.w = cvt_pk_bf16(vv[6], vv[7]);
                *(u32x4*)(D256 + (size_t)mrow * 256 + c8) = w; }
        }
#endif
#ifndef DIS_M1
        if (mk == 1) {
#ifndef DIS_F1
            { SchedF1 Sf{(const char*)D256, (const char*)ZG, YT, S, nseq * 4 * 2 * (S >> 8), G, bx};
              pg8::EpiStore<0> E{2 * S, nullptr};
              pg8::gemm_phase<pg8::EpiStore<0>, SchedF1>(lds, tid, 256, NIN, Sf, E); }
#endif
            LAS float* biasL = (LAS float*)lds;
#ifndef DIS_BIAS
            for (int idx = tid; idx < 12 * 129; idx += 512) { const int h12 = idx / 129, dd = idx - h12 * 129 - 64; const int g = h12 >> 2;
                biasL[h12 * 132 + dd + 64] = args.in[4][t5_bucket(dd * (1 << (2 * g))) * 12 + h12] * LOG2E; }
#endif
            __syncthreads();
#ifndef DIS_DIL
            for (int u = gw; u < 12 * 512; u += ngw) dil_attn_unit(ZG, LSE, biasL, S, u, lane);
#endif
#ifndef DIS_MEM
            for (int u = gw; u < 4 * 512; u += ngw) { const int w = u & 511; const int bglob = (chunk == 2 ? 16 : chunk * 8) + (w * 32) / S;
                mem_attn_unit(ZG, KV + (size_t)bglob * 256 * 2048, AFM, u, lane); }
#endif
            __syncthreads();
        }
#endif
#ifndef DIS_M2
        if (mk == 2) {
            {
                const int hS = S >> 1, per_row = S / 8, total = nseq * 1024 * per_row; const int gt = bx * 512 + tid, ngt = G * 512;
                for (int idx = gt; idx < total; idx += ngt) { const int row = idx / per_row, k8 = (idx - row * per_row) * 8; const bf16_t* yr = YT + (size_t)row * (2 * S); float vv[8];
#pragma unroll
                    for (int e = 0; e < 8; ++e) { const int kk = k8 + e;
                        if (kk == 0) vv[e] = bf_lo(yr[0]);
                        else if (kk < hS) vv[e] = bf_lo(yr[kk]) + bf_lo(yr[S - kk]);
                        else if (kk == hS) vv[e] = bf_lo(yr[hS]);
                        else { const int sidx = kk - hS; vv[e] = bf_lo(yr[S + sidx]) - bf_lo(yr[2 * S - sidx]); } }
                    u32x4 w; w.x = cvt_pk_bf16(vv[0], vv[1]); w.y = cvt_pk_bf16(vv[2], vv[3]); w.z = cvt_pk_bf16(vv[4], vv[5]); w.w = cvt_pk_bf16(vv[6], vv[7]);
                    *(u32x4*)(YF + (size_t)row * S + k8) = w; }
            }
            for (int t = gw; t < CH; t += ngw) { const int j = lane >> 4, e0 = (lane & 15) * 8;
                const float l0 = LSE[(size_t)t * 12 + j], l1 = LSE[(size_t)t * 12 + 4 + j], l2 = LSE[(size_t)t * 12 + 8 + j];
                const float mxl = fmaxf(l0, fmaxf(l1, l2)); float w0 = __builtin_amdgcn_exp2f(l0 - mxl), w1 = __builtin_amdgcn_exp2f(l1 - mxl), w2 = __builtin_amdgcn_exp2f(l2 - mxl);
                const float iw = 1.0f / (w0 + w1 + w2); w0 *= iw; w1 *= iw; w2 *= iw;
                const bf16_t* zr = ZG + (size_t)t * NIN + j * 128 + e0;
                const u32x4 a = *(const u32x4*)zr, b = *(const u32x4*)(zr + 512), c = *(const u32x4*)(zr + 1024);
                u32x4 o;
                o.x = cvt_pk_bf16(w0 * bf_lo(a.x) + w1 * bf_lo(b.x) + w2 * bf_lo(c.x), w0 * bf_hi(a.x) + w1 * bf_hi(b.x) + w2 * bf_hi(c.x));
                o.y = cvt_pk_bf16(w0 * bf_lo(a.y) + w1 * bf_lo(b.y) + w2 * bf_lo(c.y), w0 * bf_hi(a.y) + w1 * bf_hi(b.y) + w2 * bf_hi(c.y));
                o.z = cvt_pk_bf16(w0 * bf_lo(a.z) + w1 * bf_lo(b.z) + w2 * bf_lo(c.z), w0 * bf_hi(a.z) + w1 * bf_hi(b.z) + w2 * bf_hi(c.z));
                o.w = cvt_pk_bf16(w0 * bf_lo(a.w) + w1 * bf_lo(b.w) + w2 * bf_lo(c.w), w0 * bf_hi(a.w) + w1 * bf_hi(b.w) + w2 * bf_hi(c.w));
                *(u32x4*)(AFM + (size_t)t * NAFM + j * 128 + e0) = o; }
        }
#endif
        if (mk == 3) {
            SchedF2 Sf{(const char*)(chunk == 2 ? DS4 : DS2), (const char*)YF, AFM, S, nseq * (S >> 8) * 4, G, bx};
            pg8::EpiStore<0> E{NAFM, nullptr};
            pg8::gemm_phase<pg8::EpiStore<0>, SchedF2>(lds, tid, S, S, Sf, E);
        }
#ifndef DIS_M4
        if (mk == 4) {
            SchedP Sp; Sp.so.init(CH, DM, G, bx); Sp.AFM = (const char*)AFM; Sp.WP = (const char*)(ws + WS_WP); Sp.Gc = GG; Sp.Mg = YT;
            pg8::EpiGateRMW E{DM, args.in[14], NGT};
            pg8::gemm_phase<pg8::EpiGateRMW, SchedP>(lds, tid, NAFM, NAFM, Sp, E);
        }
#endif
#ifndef DIS_R6
        if (mk == 6 || ph == 27) {
            const int r0 = (ph == 27) ? 0 : (int)crow0, nr = (ph == 27) ? TT : CH;
            for (int row = gw; row < nr; row += ngw) { const size_t gr = (size_t)(r0 + row);
                const bf16_t* yr = (ph == 27) ? XN + gr * DM : ZG + (size_t)row * DM;
                if (ph == 27) row_op<true, false>(yr, out + gr * DM, out + gr * DM, nullptr, args.in[23], args.in[20], 0.5f, lane);
                else row_op<true, true>(yr, out + gr * DM, out + gr * DM, XN + gr * DM, args.in[19], args.in[20], 1.0f, lane); }
        }
#endif

#if MK_COOP
        if (pi + 1 < args.ph_hi) { if (pi == args.ph_lo) grid.sync(); else xcd_barrier(xbar); }
#endif
    }
}

extern "C" void kernel_launch(void* const* d_in, const int* in_sizes, int n_in, void* d_out, int out_size, void* d_ws, size_t ws_size, hipStream_t stream) {
    static int grid = 0;
    if (grid == 0) {
        if (n_in != 24 || out_size != TT * DM || ws_size < WS_END) { fprintf(stderr, "kernel_launch: unexpected shapes (n_in %d out %d ws %zu)\n", n_in, out_size, ws_size); grid = -1; return; }
        int dev = 0, cus = 0, per_cu = 0;
        hipGetDevice(&dev); hipDeviceGetAttribute(&cus, hipDeviceAttributeMultiprocessorCount, dev);
        if (hipFuncSetAttribute((const void*)mk_fwd, hipFuncAttributeMaxDynamicSharedMemorySize, LDS_BYTES) != hipSuccess) { fprintf(stderr, "kernel_launch: hipFuncSetAttribute failed\n"); grid = -1; return; }
        if (hipOccupancyMaxActiveBlocksPerMultiprocessor(&per_cu, (const void*)mk_fwd, 512, LDS_BYTES) != hipSuccess || per_cu < 1) { fprintf(stderr, "kernel_launch: occupancy query says %d\n", per_cu); per_cu = 1; }
        (void)hipGetLastError();
        grid = cus * 1;
    }
    if (grid < 0) return;
    Args a{};
    for (int i = 0; i < 24; ++i) a.in[i] = (const float*)d_in[i];
    a.out = (float*)d_out; a.ws = (unsigned char*)d_ws;
#if MK_COOP
    (void)hipMemsetAsync(d_ws, 0, 16384, stream);
    a.ph_lo = 0; a.ph_hi = N_PHASES + __builtin_popcount(PROBE_MASK); a.coop = 1;
    void* kargs[] = {&a};
    hipError_t e = hipLaunchCooperativeKernel((const void*)mk_fwd, dim3(grid), dim3(512), kargs, LDS_BYTES, stream);
    if (e != hipSuccess) fprintf(stderr, "cooperative launch failed: %s (grid %d)\n", hipGetErrorString(e), grid);
#else
    for (int ph = 0; ph < N_PHASES; ++ph) {
        a.ph_lo = ph; a.ph_hi = ph + 1; a.coop = 0;
        hipLaunchKernelGGL(mk_fwd, dim3(grid), dim3(512), LDS_BYTES, stream, a);
    }
#endif
}
```

```cpp
#include <hip/hip_runtime.h>
#include <hip/hip_cooperative_groups.h>
#include <cstdio>
#include <cstdint>
namespace cg = cooperative_groups;

#ifndef MK_COOP
#define MK_COOP 1
#endif

#define LAS __attribute__((address_space(3)))
typedef unsigned short bf16_t;
typedef short bf16x8 __attribute__((ext_vector_type(8)));
typedef float f32x4 __attribute__((ext_vector_type(4)));
typedef float f32x16 __attribute__((ext_vector_type(16)));
typedef unsigned u32x4 __attribute__((ext_vector_type(4)));
typedef unsigned u32x2 __attribute__((ext_vector_type(2)));

constexpr int TT = 49152, DM = 2048, DFF = 5632, NIN = 6656, NGT = 6144, CH = 16384, NAFM = 2560;
constexpr int TP = 32768;
constexpr float RMS_EPS = 1e-6f;
constexpr float LOG2E = 1.4426950408889634f;
constexpr size_t MiB = 1u << 20;
constexpr size_t WS_W1U = 1 * MiB;
constexpr size_t WS_W1D = WS_W1U + 44 * MiB;
constexpr size_t WS_YT = WS_W1D + 22 * MiB;
constexpr size_t WS_WIN = WS_YT + 66 * MiB;
constexpr size_t WS_WG = WS_WIN + 26 * MiB;
constexpr size_t WS_WKV = WS_WG + 24 * MiB;
constexpr size_t WS_WP = WS_WKV + 8 * MiB;
constexpr size_t WS_WO = WS_WP + 10 * MiB;
constexpr size_t WS_XN = WS_WO + 8 * MiB;
constexpr size_t WS_H = WS_XN + 192 * MiB;
constexpr size_t WS_ZG = WS_H;
constexpr size_t WS_GG = WS_ZG + 208 * MiB;
constexpr size_t WS_AFM = WS_GG + 192 * MiB;
constexpr size_t WS_LSE = WS_AFM + 80 * MiB;
constexpr size_t WS_MEMN = WS_LSE + 1 * MiB;
constexpr size_t WS_KV = WS_MEMN + 20 * MiB;
constexpr size_t WS_HEND = WS_H + 528 * MiB;
static_assert(WS_KV + 20 * MiB <= WS_HEND, "overlay map");
constexpr size_t WS_DS2 = WS_HEND;
constexpr size_t WS_DS4 = WS_DS2 + 8 * MiB;
constexpr size_t WS_D256 = WS_DS4 + 32 * MiB;
constexpr size_t WS_YF = WS_D256 + 1 * MiB;
constexpr size_t WS_END = WS_YF + 32 * MiB;
static_assert(WS_END <= 1024 * MiB, "workspace");

constexpr int LDS_BYTES = 140288;

__device__ __forceinline__ unsigned cvt_pk_bf16(float lo, float hi) { unsigned r; asm volatile("v_cvt_pk_bf16_f32 %0, %1, %2" : "=v"(r) : "v"(lo), "v"(hi)); return r; }
__device__ __forceinline__ float bf_lo(unsigned u) { return __uint_as_float(u << 16); }
__device__ __forceinline__ float bf_hi(unsigned u) { return __uint_as_float(u & 0xffff0000u); }
__device__ __forceinline__ float wave_sum(float v) {
#pragma unroll
    for (int o = 1; o < 64; o <<= 1) v += __shfl_xor(v, o);
    return v;
}
__device__ __forceinline__ float sigmoidf_(float x) { return __builtin_amdgcn_rcpf(1.0f + __builtin_amdgcn_exp2f(-x * LOG2E)); }

namespace pg8 {
constexpr int BM = 256, BK = 64, HALF = 128, HTB = HALF * BK * 2, STAGE_BYTES = 8 * HTB, NXCD = 8, WGM = 4;
__host__ __device__ __forceinline__ int lds_byte(int r, int c) { const int st = (r >> 4) * 2 + (c >> 5), rr = r & 15, cc = c & 31, ob = rr * 64 + cc * 2; return st * 1024 + (ob ^ (((ob >> 9) & 1) << 5)); }
__host__ __device__ __forceinline__ void stage_rc(int b, int& R, int& C) { const int st = b / 1024, sb = b % 1024, swz = sb ^ (((sb >> 9) & 1) << 5); R = (st >> 1) * 16 + swz / 64; C = (st & 1) * 32 + (swz % 64) / 2; }
__host__ __device__ __forceinline__ int perm32(int rho) { const int n = rho >> 4, i = rho & 15; return 8 * (i >> 2) + 4 * n + (i & 3); }

struct Unit { const char* A; const char* B; bf16_t* C; const bf16_t* C2; int nt; int aux; };
struct PN { int pm, pn; };
struct StaticOrder {
    int nM, nN, nwg, G, c;
    __device__ void init(int M, int N, int G_, int c_) { nM = M / BM; nN = N / BM; nwg = nM * nN; G = G_; c = c_; }
    __device__ bool next(int i, PN& u) const {
        const long L = (long)i * G + c; if (L >= nwg) return false;
        int wgid = (int)L; { const int q = nwg / NXCD, r = nwg % NXCD, xcd = wgid % NXCD, off = wgid / NXCD; wgid = (xcd < r ? xcd * (q + 1) : r * (q + 1) + (xcd - r) * q) + off; }
        const int nig = WGM * nN, gid = wgid / nig, fm = gid * WGM, gsz = (nM - fm) < WGM ? (nM - fm) : WGM;
        u.pm = fm + ((wgid % nig) % gsz); u.pn = (wgid % nig) / gsz; return true;
    }
};

template <int ACT> struct EpiStore {
    int ldc; const float* bias;
    __device__ __forceinline__ void operator()(const f32x4 (&acc)[2][2][4][2], const Unit& u, int wr, int wc, int fr, int fq) const {
        bf16_t* base = u.C + (size_t)(wr * 64 + fr) * ldc + wc * 32 + 8 * fq;
        f32x4 bv[2][2];
        if (ACT == 1) {
#pragma unroll
            for (int bj = 0; bj < 2; ++bj)
#pragma unroll
                for (int n = 0; n < 2; ++n) bv[bj][n] = *(const f32x4*)(bias + u.aux + bj * HALF + wc * 32 + 8 * fq + 4 * n);
        }
#pragma unroll
        for (int ai = 0; ai < 2; ++ai)
#pragma unroll
            for (int m = 0; m < 4; ++m) { bf16_t* rowp = base + (size_t)(ai * HALF + m * 16) * ldc;
#pragma unroll
                for (int bj = 0; bj < 2; ++bj) { f32x4 v0 = acc[ai][bj][m][0], v1 = acc[ai][bj][m][1];
                    if (ACT == 1) { v0 = v0 + bv[bj][0]; v1 = v1 + bv[bj][1];
#pragma unroll
                        for (int e = 0; e < 4; ++e) { v0[e] = sigmoidf_(v0[e]); v1[e] = sigmoidf_(v1[e]); } }
                    u32x4 w; w.x = cvt_pk_bf16(v0[0], v0[1]); w.y = cvt_pk_bf16(v0[2], v0[3]); w.z = cvt_pk_bf16(v1[0], v1[1]); w.w = cvt_pk_bf16(v1[2], v1[3]);
                    *(u32x4*)(rowp + bj * HALF) = w; } }
    }
};
struct EpiSwiGLU {
    int ldc;
    __device__ __forceinline__ void operator()(const f32x4 (&acc)[2][2][4][2], const Unit& u, int wr, int wc, int fr, int fq) const {
        bf16_t* base = u.C + (size_t)(wr * 64 + fr) * ldc + wc * 32 + 8 * fq;
#pragma unroll
        for (int ai = 0; ai < 2; ++ai)
#pragma unroll
            for (int m = 0; m < 4; ++m) { bf16_t* rowp = base + (size_t)(ai * HALF + m * 16) * ldc;
                f32x4 v0, v1;
#pragma unroll
                for (int e = 0; e < 4; ++e) { const float a0 = acc[ai][0][m][0][e], a1 = acc[ai][0][m][1][e];
                    v0[e] = a0 * sigmoidf_(a0) * acc[ai][1][m][0][e]; v1[e] = a1 * sigmoidf_(a1) * acc[ai][1][m][1][e]; }
                u32x4 w; w.x = cvt_pk_bf16(v0[0], v0[1]); w.y = cvt_pk_bf16(v0[2], v0[3]); w.z = cvt_pk_bf16(v1[0], v1[1]); w.w = cvt_pk_bf16(v1[2], v1[3]);
                *(u32x4*)rowp = w; }
    }
};
struct EpiGateRMW {
    int ldc; const float* bias; int ldg;
    __device__ __forceinline__ void operator()(const f32x4 (&acc)[2][2][4][2], const Unit& u, int wr, int wc, int fr, int fq) const {
        const size_t off0 = (size_t)(wr * 64 + fr) * ldc + wc * 32 + 8 * fq, goff0 = (size_t)(wr * 64 + fr) * ldg + wc * 32 + 8 * fq;
        f32x4 bv[2][2];
#pragma unroll
        for (int bj = 0; bj < 2; ++bj)
#pragma unroll
            for (int n = 0; n < 2; ++n) bv[bj][n] = *(const f32x4*)(bias + (u.aux >> 2) + bj * HALF + wc * 32 + 8 * fq + 4 * n);
#pragma unroll
        for (int ai = 0; ai < 2; ++ai)
#pragma unroll
            for (int m = 0; m < 4; ++m) { const size_t ro = off0 + (size_t)(ai * HALF + m * 16) * ldc, go = goff0 + (size_t)(ai * HALF + m * 16) * ldg;
#pragma unroll
                for (int bj = 0; bj < 2; ++bj) {
                    const u32x4 g = *(const u32x4*)(u.C2 + go + bj * HALF);
                    u32x4 o = (u32x4){0u, 0u, 0u, 0u}; if (u.aux & 3) o = *(const u32x4*)(u.C + ro + bj * HALF);
                    const f32x4 a0 = acc[ai][bj][m][0], a1 = acc[ai][bj][m][1];
                    const f32x4 b0 = bv[bj][0], b1 = bv[bj][1];
                    u32x4 w;
                    w.x = cvt_pk_bf16(bf_lo(o.x) + sigmoidf_(bf_lo(g.x) + b0[0]) * a0[0], bf_hi(o.x) + sigmoidf_(bf_hi(g.x) + b0[1]) * a0[1]);
                    w.y = cvt_pk_bf16(bf_lo(o.y) + sigmoidf_(bf_lo(g.y) + b0[2]) * a0[2], bf_hi(o.y) + sigmoidf_(bf_hi(g.y) + b0[3]) * a0[3]);
                    w.z = cvt_pk_bf16(bf_lo(o.z) + sigmoidf_(bf_lo(g.z) + b1[0]) * a1[0], bf_hi(o.z) + sigmoidf_(bf_hi(g.z) + b1[1]) * a1[1]);
                    w.w = cvt_pk_bf16(bf_lo(o.w) + sigmoidf_(bf_lo(g.w) + b1[2]) * a1[2], bf_hi(o.w) + sigmoidf_(bf_hi(g.w) + b1[3]) * a1[3]);
                    *(u32x4*)(u.C + ro + bj * HALF) = w; } }
    }
};

template <class Epi, class Sched>
__device__ __forceinline__ void gemm_phase(LAS unsigned char* lds, const int tid, const int lda, const int ldb, const Sched& S, const Epi& E) {
    const int wid = __builtin_amdgcn_readfirstlane(tid >> 6), lane = tid & 63, wr = wid >> 2, wc = wid & 3, fr = lane & 15, fq = lane >> 4;
    unsigned voffA[2], voffB[2];
#pragma unroll
    for (int i = 0; i < 2; ++i) { int R, C; stage_rc(tid * 16 + i * 8192, R, C); const int Rb = (R & ~31) + perm32(R & 31);
        voffA[i] = (unsigned)(R * lda + C) * 2u; voffB[i] = (unsigned)(Rb * ldb + C) * 2u; }
    const size_t kstep = (size_t)(BK * 2);
    const size_t hstepA = (size_t)HALF * lda * 2, hstepB = (size_t)HALF * ldb * 2;
    const unsigned ldsw = (unsigned)wid * 1024u;
    const int aoff = lds_byte(wr * 64 + fr, fq * 8), boff = lds_byte(wc * 32 + fr, fq * 8);
#define PG8_SA(b, h) (((b) * 2 + (h)) * HTB)
#define PG8_SB(b, h) ((4 + (b) * 2 + (h)) * HTB)
#define PG8_STAGE(bufoff, gbase, voff) do { _Pragma("unroll") for (int _i = 0; _i < 2; ++_i) \
        __builtin_amdgcn_global_load_lds((const unsigned*)((const char*)(gbase) + (voff)[_i]), (LAS unsigned*)(lds + (bufoff) + ldsw + _i * 8192), 16, 0, 0); } while (0)
#define PG8_LDA(dst, b, h) do { _Pragma("unroll") for (int m = 0; m < 4; ++m) _Pragma("unroll") for (int k = 0; k < 2; ++k) dst[m][k] = *(const LAS bf16x8*)(lds + PG8_SA(b, h) + aoff + m * 2048 + k * 1024); } while (0)
#define PG8_LDB(dst, b, h) do { _Pragma("unroll") for (int n = 0; n < 2; ++n) _Pragma("unroll") for (int k = 0; k < 2; ++k) dst[n][k] = *(const LAS bf16x8*)(lds + PG8_SB(b, h) + boff + n * 2048 + k * 1024); } while (0)
#define PG8_MMA(ai, bj, At, Bt) do { __builtin_amdgcn_s_setprio(1); _Pragma("unroll") for (int m = 0; m < 4; ++m) _Pragma("unroll") for (int n = 0; n < 2; ++n) _Pragma("unroll") for (int k = 0; k < 2; ++k) \
        acc[ai][bj][m][n] = __builtin_amdgcn_mfma_f32_16x16x32_bf16(Bt[n][k], At[m][k], acc[ai][bj][m][n], 0, 0, 0); __builtin_amdgcn_s_setprio(0); } while (0)
#define PG8_WAIT_V(n) asm volatile("s_waitcnt vmcnt(" #n ")" ::: "memory")
#define PG8_WAIT_L(n) asm volatile("s_waitcnt lgkmcnt(" #n ")" ::: "memory")
#define PG8_BAR __builtin_amdgcn_s_barrier()
#define PG8_SCHED __builtin_amdgcn_sched_barrier(0)
    Unit cur, nxt; int ui = 0;
    if (!S.next(0, cur)) return;
    f32x4 acc[2][2][4][2];
#pragma unroll
    for (int a = 0; a < 2; ++a)
#pragma unroll
        for (int b = 0; b < 2; ++b)
#pragma unroll
            for (int m = 0; m < 4; ++m)
#pragma unroll
                for (int n = 0; n < 2; ++n) acc[a][b][m][n] = (f32x4){0.f, 0.f, 0.f, 0.f};
    bf16x8 At[4][2], B0[2][2], B1[2][2];
    const char* cA = cur.A; const char* cB = cur.B;
    PG8_STAGE(PG8_SB(0, 0), cB, voffB); PG8_STAGE(PG8_SB(0, 1), cB + hstepB, voffB); PG8_STAGE(PG8_SA(0, 0), cA, voffA); PG8_STAGE(PG8_SA(0, 1), cA + hstepA, voffA);
    if (wr == 1) PG8_BAR;
    PG8_WAIT_V(2); PG8_BAR;
    PG8_STAGE(PG8_SB(1, 0), cB + kstep, voffB); PG8_STAGE(PG8_SA(1, 0), cA + kstep, voffA); PG8_STAGE(PG8_SB(1, 1), cB + hstepB + kstep, voffB);
    PG8_WAIT_V(6); PG8_BAR;
    for (;;) {
        const bool has_next = S.next(ui + 1, nxt);
        const char* nA = has_next ? nxt.A : cA; const char* nB = has_next ? nxt.B : cB;
        int nt = cur.nt; asm volatile("" : "+s"(nt));
        for (int t = 0; t < nt; t += 2) {
            const bool last = (t == nt - 2);
            const char* a1 = cA + (size_t)(t + 1) * kstep;
            const char* a2 = last ? nA : cA + (size_t)(t + 2) * kstep; const char* b2 = last ? nB : cB + (size_t)(t + 2) * kstep;
            const char* a3 = a2 + kstep; const char* b3 = b2 + kstep;
            PG8_LDB(B0, 0, 0); PG8_LDB(B1, 0, 1); PG8_SCHED; PG8_LDA(At, 0, 0); PG8_STAGE(PG8_SA(1, 1), a1 + hstepA, voffA);
            PG8_WAIT_V(8); PG8_WAIT_L(0); PG8_BAR; PG8_MMA(0, 0, At, B0); PG8_MMA(0, 1, At, B1); PG8_BAR; PG8_SCHED;
            PG8_LDA(At, 0, 1); PG8_STAGE(PG8_SB(0, 0), b2, voffB); PG8_STAGE(PG8_SB(0, 1), b2 + hstepB, voffB); PG8_STAGE(PG8_SA(0, 0), a2, voffA);
            PG8_WAIT_V(8); PG8_WAIT_L(0); PG8_BAR; PG8_MMA(1, 0, At, B0); PG8_MMA(1, 1, At, B1); PG8_BAR; PG8_SCHED;
            PG8_LDB(B0, 1, 0); PG8_LDB(B1, 1, 1); PG8_SCHED; PG8_LDA(At, 1, 0); PG8_STAGE(PG8_SA(0, 1), a2 + hstepA, voffA);
            PG8_WAIT_V(8); PG8_WAIT_L(0); PG8_BAR; PG8_MMA(0, 0, At, B0); PG8_MMA(0, 1, At, B1); PG8_BAR; PG8_SCHED;
            PG8_LDA(At, 1, 1); PG8_STAGE(PG8_SB(1, 0), b3, voffB); PG8_STAGE(PG8_SB(1, 1), b3 + hstepB, voffB); PG8_STAGE(PG8_SA(1, 0), a3, voffA);
            PG8_WAIT_V(8); PG8_WAIT_L(0); PG8_BAR; PG8_MMA(1, 0, At, B0); PG8_MMA(1, 1, At, B1); PG8_BAR; PG8_SCHED;
        }
        if (wr == 0) PG8_BAR;
        E(acc, cur, wr, wc, fr, fq);
        if (!has_next) break;
#pragma unroll
        for (int a = 0; a < 2; ++a)
#pragma unroll
            for (int b = 0; b < 2; ++b)
#pragma unroll
                for (int m = 0; m < 4; ++m)
#pragma unroll
                    for (int n = 0; n < 2; ++n) acc[a][b][m][n] = (f32x4){0.f, 0.f, 0.f, 0.f};
        cur = nxt; cA = nA; cB = nB; ++ui;
        if (wr == 1) PG8_BAR;
    }
    PG8_WAIT_V(0);
    PG8_BAR;
#undef PG8_SA
#undef PG8_SB
#undef PG8_STAGE
#undef PG8_LDA
#undef PG8_LDB
#undef PG8_MMA
#undef PG8_WAIT_V
#undef PG8_WAIT_L
#undef PG8_BAR
#undef PG8_SCHED
}
}

struct SchedStd {
    pg8::StaticOrder so; const char* A; const char* B; bf16_t* C; size_t a_tile, b_tile; int ldc, ccols, nt;
    __device__ __forceinline__ bool next(int i, pg8::Unit& u) const {
        pg8::PN p; if (!so.next(i, p)) return false;
        u.A = A + (size_t)p.pm * a_tile; u.B = B + (size_t)p.pn * b_tile; u.C = C + (size_t)p.pm * 256 * ldc + (size_t)p.pn * ccols; u.C2 = nullptr; u.nt = nt; u.aux = p.pn * 256; return true; }
};
struct SchedF1 {
    const char* D; const char* Z; bf16_t* Yt; int S, nunits, G, c;
    __device__ __forceinline__ bool next(int i, pg8::Unit& u) const {
        const int L = i * G + c; if (L >= nunits) return false;
        const int lg = (S == 4096) ? 4 : 3; const int pn = L & ((1 << lg) - 1); int t = L >> lg; const int pm = t & 1; t >>= 1; const int g = t & 3; const int b = t >> 2;
        u.A = D + (size_t)pm * 256 * 256 * 2; u.B = Z + ((size_t)(b * S + pn * 256) * NIN + 4608 + g * 256) * 2;
        u.C = Yt + (size_t)(b * 1024 + g * 256) * (2 * S) + (size_t)pm * S + pn * 256; u.C2 = nullptr; u.nt = 4; u.aux = 0; return true; }
};
struct SchedF2 {
    const char* DS; const char* Yt; bf16_t* AFM; int S, nunits, G, c;
    __device__ __forceinline__ bool next(int i, pg8::Unit& u) const {
        const int L = i * G + c; if (L >= nunits) return false;
        const int lg = (S == 4096) ? 4 : 3; const int pn = L & 3; const int t = L >> 2; const int pm = t & ((1 << lg) - 1); const int b = t >> lg;
        u.A = DS + (size_t)pm * 256 * S * 2; u.B = Yt + (size_t)(b * 1024 + pn * 256) * S * 2;
        u.C = AFM + (size_t)(b * S + pm * 256) * NAFM + 512 + pn * 256; u.C2 = nullptr; u.nt = S >> 6; u.aux = 0; return true; }
};
struct SchedP {
    pg8::StaticOrder so; const char* AFM; const char* WP; const bf16_t* Gc; bf16_t* Mg;
    __device__ __forceinline__ bool next(int i, pg8::Unit& u) const {
        const int j = i / 3, b = i - 3 * j; pg8::PN p; if (!so.next(j, p)) return false;
        const int koff = (b == 0) ? 0 : (b == 1 ? 512 : 1536);
        u.A = AFM + ((size_t)p.pm * 256 * NAFM + koff) * 2; u.B = WP + ((size_t)p.pn * 256 * NAFM + koff) * 2;
        u.C = Mg + (size_t)p.pm * 256 * DM + p.pn * 256; u.C2 = Gc + (size_t)p.pm * 256 * NGT + b * 2048 + p.pn * 256; u.nt = (b == 0) ? 8 : 16; u.aux = b + 4 * (b * 2048 + p.pn * 256); return true; }
};

template <bool XIN_BF16, bool XOUT_BF16>
__device__ __forceinline__ void row_op(const bf16_t* y, const void* xin_, void* xout_, bf16_t* xn, const float* g_post, const float* g_pre, float cres, int lane) {
    float v[32];
    if (XIN_BF16) { const bf16_t* xin = (const bf16_t*)xin_;
#pragma unroll
        for (int j = 0; j < 4; ++j) { const u32x4 w = *(const u32x4*)(xin + j * 512 + lane * 8);
            v[j * 8 + 0] = bf_lo(w.x); v[j * 8 + 1] = bf_hi(w.x); v[j * 8 + 2] = bf_lo(w.y); v[j * 8 + 3] = bf_hi(w.y);
            v[j * 8 + 4] = bf_lo(w.z); v[j * 8 + 5] = bf_hi(w.z); v[j * 8 + 6] = bf_lo(w.w); v[j * 8 + 7] = bf_hi(w.w); }
    } else { const float* xin = (const float*)xin_;
#pragma unroll
    for (int j = 0; j < 4; ++j) { const int e0 = j * 512 + lane * 8; const f32x4 a = *(const f32x4*)(xin + e0), b = *(const f32x4*)(xin + e0 + 4);
#pragma unroll
        for (int e = 0; e < 4; ++e) { v[j * 8 + e] = a[e]; v[j * 8 + 4 + e] = b[e]; } }
    }
    if (y) {
        float yv[32]; float ss = 0.f;
#pragma unroll
        for (int j = 0; j < 4; ++j) { const u32x4 w = *(const u32x4*)(y + j * 512 + lane * 8);
            yv[j * 8 + 0] = bf_lo(w.x); yv[j * 8 + 1] = bf_hi(w.x); yv[j * 8 + 2] = bf_lo(w.y); yv[j * 8 + 3] = bf_hi(w.y);
            yv[j * 8 + 4] = bf_lo(w.z); yv[j * 8 + 5] = bf_hi(w.z); yv[j * 8 + 6] = bf_lo(w.w); yv[j * 8 + 7] = bf_hi(w.w); }
#pragma unroll
        for (int i = 0; i < 32; ++i) ss += yv[i] * yv[i];
        ss = wave_sum(ss);
        const float rs = cres * (1.0f / sqrtf(ss * (1.0f / DM) + RMS_EPS));
#pragma unroll
        for (int j = 0; j < 4; ++j) { const int e0 = j * 512 + lane * 8; const f32x4 a = *(const f32x4*)(g_post + e0), b = *(const f32x4*)(g_post + e0 + 4);
#pragma unroll
            for (int e = 0; e < 4; ++e) { v[j * 8 + e] += yv[j * 8 + e] * rs * a[e]; v[j * 8 + 4 + e] += yv[j * 8 + 4 + e] * rs * b[e]; } }
    }
    if (xout_) {
        if (XOUT_BF16) { bf16_t* xout = (bf16_t*)xout_;
#pragma unroll
            for (int j = 0; j < 4; ++j) { u32x4 w; w.x = cvt_pk_bf16(v[j * 8 + 0], v[j * 8 + 1]); w.y = cvt_pk_bf16(v[j * 8 + 2], v[j * 8 + 3]); w.z = cvt_pk_bf16(v[j * 8 + 4], v[j * 8 + 5]); w.w = cvt_pk_bf16(v[j * 8 + 6], v[j * 8 + 7]);
                *(u32x4*)(xout + j * 512 + lane * 8) = w; }
        } else { float* xout = (float*)xout_;
#pragma unroll
        for (int j = 0; j < 4; ++j) { const int e0 = j * 512 + lane * 8;
            *(f32x4*)(xout + e0) = (f32x4){v[j * 8 + 0], v[j * 8 + 1], v[j * 8 + 2], v[j * 8 + 3]};
            *(f32x4*)(xout + e0 + 4) = (f32x4){v[j * 8 + 4], v[j * 8 + 5], v[j * 8 + 6], v[j * 8 + 7]}; }
        }
    }
    if (xn) {
        float ss = 0.f;
#pragma unroll
        for (int i = 0; i < 32; ++i) ss += v[i] * v[i];
        ss = wave_sum(ss);
        const float rs = 1.0f / sqrtf(ss * (1.0f / DM) + RMS_EPS);
#pragma unroll
        for (int j = 0; j < 4; ++j) { const int e0 = j * 512 + lane * 8; const f32x4 a = *(const f32x4*)(g_pre + e0), b = *(const f32x4*)(g_pre + e0 + 4);
            u32x4 w; w.x = cvt_pk_bf16(v[j * 8 + 0] * rs * a[0], v[j * 8 + 1] * rs * a[1]); w.y = cvt_pk_bf16(v[j * 8 + 2] * rs * a[2], v[j * 8 + 3] * rs * a[3]);
            w.z = cvt_pk_bf16(v[j * 8 + 4] * rs * b[0], v[j * 8 + 5] * rs * b[1]); w.w = cvt_pk_bf16(v[j * 8 + 6] * rs * b[2], v[j * 8 + 7] * rs * b[3]);
            *(u32x4*)(xn + e0) = w; }
    }
}

__device__ __forceinline__ void transpose_item(const float* W, int N, bf16_t* WT, int ldk, int koff, int row_off, int k0, int n0, LAS float* scr, int lane) {
#pragma unroll 16
    for (int i = 0; i < 64; ++i) scr[i * 65 + lane] = W[(size_t)(k0 + i) * N + n0 + lane];
    asm volatile("s_waitcnt lgkmcnt(0)" ::: "memory");
    const int c = lane & 7;
#pragma unroll
    for (int j = 0; j < 8; ++j) { const int n = (lane >> 3) + 8 * j; const LAS float* s = scr + (8 * c) * 65 + n;
        u32x4 o; o.x = cvt_pk_bf16(s[0 * 65], s[1 * 65]); o.y = cvt_pk_bf16(s[2 * 65], s[3 * 65]); o.z = cvt_pk_bf16(s[4 * 65], s[5 * 65]); o.w = cvt_pk_bf16(s[6 * 65], s[7 * 65]);
        *(u32x4*)(WT + (size_t)(row_off + n) * ldk + koff + k0 + 8 * c) = o; }
    asm volatile("s_waitcnt lgkmcnt(0)" ::: "memory");
}
__device__ __forceinline__ void convert_weight(const float* W, int K, int N, bf16_t* WT, int ldk, int koff, bool swiglu_perm, LAS float* scr, int gw, int ngw, int lane) {
    const int nblk = N / 64, nitems = (K / 64) * nblk;
    for (int it = gw; it < nitems; it += ngw) {
        const int kb = it / nblk, nb = it - kb * nblk, n0 = nb * 64;
        int row_off = n0;
        if (swiglu_perm) { const int half = (n0 >= DFF) ? 1 : 0; const int n1 = n0 - half * DFF; row_off = (n1 >> 7) * 256 + half * 128 + (n1 & 127); }
        transpose_item(W, N, WT, ldk, koff, row_off, kb * 64, n0, scr, lane);
    }
}

__device__ __forceinline__ int crow(int r, int hi) { return (r & 3) + 8 * (r >> 2) + 4 * hi; }
__device__ __forceinline__ bf16x8 pack8(const f32x16& s, int b) {
    u32x4 w; w.x = cvt_pk_bf16(s[b + 0], s[b + 1]); w.y = cvt_pk_bf16(s[b + 2], s[b + 3]); w.z = cvt_pk_bf16(s[b + 4], s[b + 5]); w.w = cvt_pk_bf16(s[b + 6], s[b + 7]);
    return __builtin_bit_cast(bf16x8, w);
}
__device__ __forceinline__ void dil_attn_unit(bf16_t* z, float* lse, const LAS float* biasL, int S, int unit, int lane) {
    const int h12 = unit >> 9, w = unit & 511;
    const int g = h12 >> 2, sh = 2 * g, L = S >> sh;
    const int spb = S >> 5; const int b = w / spb, v = w - b * spb; const int nlb = L >> 5; const int r = v / nlb, lb = v - r * nlb; const int l0 = lb * 32;
    const int q = lane & 31, hi = lane >> 5; const int lq = l0 + q;
    const size_t seqbase = (size_t)b * S;
    bf16_t* qrow = z + (seqbase + ((size_t)lq << sh) + r) * NIN + h12 * 128;
    bf16x8 qf[8];
#pragma unroll
    for (int ks = 0; ks < 8; ++ks) qf[ks] = *(const bf16x8*)(qrow + ks * 16 + hi * 8);
    f32x16 o[4];
#pragma unroll
    for (int dt = 0; dt < 4; ++dt)
#pragma unroll
        for (int i = 0; i < 16; ++i) o[dt][i] = 0.f;
    float m = -1e30f, lsum = 0.f;
    const float sc = 0.08838834764831845f * LOG2E;
    const LAS float* bl = biasL + h12 * 132 + 64;
    const int kt_lo = (l0 < 64) ? (2 - (l0 >> 5)) : 0; int kt_hi = (L - l0 + 64) >> 5; kt_hi = kt_hi > 5 ? 5 : kt_hi;
    bf16x8 kfn[8];
    { int kl = l0 - 64 + kt_lo * 32 + q; kl = kl < 0 ? 0 : (kl > L - 1 ? L - 1 : kl);
      const bf16_t* kp = z + (seqbase + ((size_t)kl << sh) + r) * NIN + 1536 + h12 * 128 + hi * 8;
#pragma unroll
      for (int ks = 0; ks < 8; ++ks) kfn[ks] = *(const bf16x8*)(kp + ks * 16); }
    for (int kt = kt_lo; kt < kt_hi; ++kt) {
        const int kl0 = l0 - 64 + kt * 32;
        u32x2 vv[2][8];
#pragma unroll
        for (int s_ = 0; s_ < 2; ++s_)
#pragma unroll
            for (int i = 0; i < 8; ++i) { int lk = kl0 + crow(8 * s_ + i, hi); lk = lk < 0 ? 0 : (lk > L - 1 ? L - 1 : lk);
                vv[s_][i] = *(const u32x2*)(z + (seqbase + ((size_t)lk << sh) + r) * NIN + 3072 + h12 * 128 + 4 * q); }
        f32x16 s;
#pragma unroll
        for (int i = 0; i < 16; ++i) s[i] = 0.f;
#pragma unroll
        for (int ks = 0; ks < 8; ++ks) s = __builtin_amdgcn_mfma_f32_32x32x16_bf16(kfn[ks], qf[ks], s, 0, 0, 0);
        if (kt + 1 < kt_hi) {
            int kl = kl0 + 32 + q; kl = kl < 0 ? 0 : (kl > L - 1 ? L - 1 : kl);
            const bf16_t* kp = z + (seqbase + ((size_t)kl << sh) + r) * NIN + 1536 + h12 * 128 + hi * 8;
#pragma unroll
            for (int ks = 0; ks < 8; ++ks) kfn[ks] = *(const bf16x8*)(kp + ks * 16); }
        float mx = -1e30f;
#pragma unroll
        for (int i = 0; i < 16; ++i) { const int lk = kl0 + crow(i, hi); const int dl = lk - lq; const bool valid = (dl >= -64) && (dl <= 64) && (lk >= 0) && (lk < L);
            const int di = dl < -64 ? -64 : (dl > 64 ? 64 : dl);
            const float vvv = valid ? (s[i] * sc + bl[di]) : -1e30f; s[i] = vvv; mx = fmaxf(mx, vvv); }
        mx = fmaxf(mx, __shfl_xor(mx, 32));
        const float mn = fmaxf(m, mx); const float f = __builtin_amdgcn_exp2f(m - mn); m = mn;
        float ps = 0.f;
#pragma unroll
        for (int i = 0; i < 16; ++i) { const float p = __builtin_amdgcn_exp2f(s[i] - mn); s[i] = p; ps += p; }
        lsum = lsum * f + ps;
#pragma unroll
        for (int dt = 0; dt < 4; ++dt)
#pragma unroll
            for (int i = 0; i < 16; ++i) o[dt][i] *= f;
        const bf16x8 pa0 = pack8(s, 0), pa1 = pack8(s, 8);
#pragma unroll
        for (int s_ = 0; s_ < 2; ++s_) {
#pragma unroll
            for (int dt = 0; dt < 4; ++dt) { u32x4 w;
                const unsigned sel = (dt & 1) ? 0x07060302u : 0x05040100u;
                if (dt < 2) { w.x = __builtin_amdgcn_perm(vv[s_][1].x, vv[s_][0].x, sel); w.y = __builtin_amdgcn_perm(vv[s_][3].x, vv[s_][2].x, sel); w.z = __builtin_amdgcn_perm(vv[s_][5].x, vv[s_][4].x, sel); w.w = __builtin_amdgcn_perm(vv[s_][7].x, vv[s_][6].x, sel); }
                else        { w.x = __builtin_amdgcn_perm(vv[s_][1].y, vv[s_][0].y, sel); w.y = __builtin_amdgcn_perm(vv[s_][3].y, vv[s_][2].y, sel); w.z = __builtin_amdgcn_perm(vv[s_][5].y, vv[s_][4].y, sel); w.w = __builtin_amdgcn_perm(vv[s_][7].y, vv[s_][6].y, sel); }
                o[dt] = __builtin_amdgcn_mfma_f32_32x32x16_bf16(__builtin_bit_cast(bf16x8, w), s_ ? pa1 : pa0, o[dt], 0, 0, 0); }
        }
    }
    lsum += __shfl_xor(lsum, 32);
    const float inv = 1.0f / lsum;
#pragma unroll
    for (int rg = 0; rg < 4; ++rg) {
        u32x4 w0, w1;
        w0.x = cvt_pk_bf16(o[0][4 * rg + 0] * inv, o[1][4 * rg + 0] * inv); w0.y = cvt_pk_bf16(o[2][4 * rg + 0] * inv, o[3][4 * rg + 0] * inv);
        w0.z = cvt_pk_bf16(o[0][4 * rg + 1] * inv, o[1][4 * rg + 1] * inv); w0.w = cvt_pk_bf16(o[2][4 * rg + 1] * inv, o[3][4 * rg + 1] * inv);
        w1.x = cvt_pk_bf16(o[0][4 * rg + 2] * inv, o[1][4 * rg + 2] * inv); w1.y = cvt_pk_bf16(o[2][4 * rg + 2] * inv, o[3][4 * rg + 2] * inv);
        w1.z = cvt_pk_bf16(o[0][4 * rg + 3] * inv, o[1][4 * rg + 3] * inv); w1.w = cvt_pk_bf16(o[2][4 * rg + 3] * inv, o[3][4 * rg + 3] * inv);
        *(u32x4*)(qrow + 32 * rg + 16 * hi) = w0; *(u32x4*)(qrow + 32 * rg + 16 * hi + 8) = w1; }
    if (hi == 0) lse[(seqbase + ((size_t)lq << sh) + r) * 12 + h12] = m + log2f(lsum);
}
__device__ __forceinline__ void mem_attn_unit(const bf16_t* z, const bf16_t* KVb, bf16_t* afm, int unit, int lane) {
    const int h = unit >> 9, w = unit & 511;
    const int q = lane & 31, hi = lane >> 5;
    const bf16_t* qp = z + (size_t)(w * 32 + q) * NIN + 5632 + h * 256 + hi * 8;
    f32x16 o[8];
#pragma unroll
    for (int dt = 0; dt < 8; ++dt)
#pragma unroll
        for (int i = 0; i < 16; ++i) o[dt][i] = 0.f;
    float m = -1e30f, lsum = 0.f;
    const float sc = 0.0625f * LOG2E;
    for (int kt = 0; kt < 8; ++kt) {
        const bf16_t* kp = KVb + (size_t)(kt * 32 + q) * 2048 + h * 256 + hi * 8;
        const bf16_t* vb = KVb + (size_t)(kt * 32) * 2048 + 1024 + h * 256 + 8 * q;
        u32x4 vv0[8], vv1[8];
#pragma unroll
        for (int i = 0; i < 8; ++i) vv0[i] = *(const u32x4*)(vb + (size_t)crow(i, hi) * 2048);
        f32x16 s;
#pragma unroll
        for (int i = 0; i < 16; ++i) s[i] = 0.f;
#pragma unroll
        for (int ks = 0; ks < 16; ++ks) { const bf16x8 kf = *(const bf16x8*)(kp + ks * 16); const bf16x8 qf = *(const bf16x8*)(qp + ks * 16); s = __builtin_amdgcn_mfma_f32_32x32x16_bf16(kf, qf, s, 0, 0, 0); }
        float mx = -1e30f;
#pragma unroll
        for (int i = 0; i < 16; ++i) { s[i] *= sc; mx = fmaxf(mx, s[i]); }
        mx = fmaxf(mx, __shfl_xor(mx, 32));
        const float mn = fmaxf(m, mx); const float f = __builtin_amdgcn_exp2f(m - mn); m = mn;
        float ps = 0.f;
#pragma unroll
        for (int i = 0; i < 16; ++i) { const float p = __builtin_amdgcn_exp2f(s[i] - mn); s[i] = p; ps += p; }
        lsum = lsum * f + ps;
#pragma unroll
        for (int dt = 0; dt < 8; ++dt)
#pragma unroll
            for (int i = 0; i < 16; ++i) o[dt][i] *= f;
        const bf16x8 pa0 = pack8(s, 0), pa1 = pack8(s, 8);
#pragma unroll
        for (int i = 0; i < 8; ++i) vv1[i] = *(const u32x4*)(vb + (size_t)crow(8 + i, hi) * 2048);
#pragma unroll
        for (int dt = 0; dt < 8; ++dt) { u32x4 w;
            const unsigned sel = (dt & 1) ? 0x07060302u : 0x05040100u; const int c = dt >> 1;
            w.x = __builtin_amdgcn_perm(vv0[1][c], vv0[0][c], sel); w.y = __builtin_amdgcn_perm(vv0[3][c], vv0[2][c], sel); w.z = __builtin_amdgcn_perm(vv0[5][c], vv0[4][c], sel); w.w = __builtin_amdgcn_perm(vv0[7][c], vv0[6][c], sel);
            o[dt] = __builtin_amdgcn_mfma_f32_32x32x16_bf16(__builtin_bit_cast(bf16x8, w), pa0, o[dt], 0, 0, 0); }
#pragma unroll
        for (int dt = 0; dt < 8; ++dt) { u32x4 w;
            const unsigned sel = (dt & 1) ? 0x07060302u : 0x05040100u; const int c = dt >> 1;
            w.x = __builtin_amdgcn_perm(vv1[1][c], vv1[0][c], sel); w.y = __builtin_amdgcn_perm(vv1[3][c], vv1[2][c], sel); w.z = __builtin_amdgcn_perm(vv1[5][c], vv1[4][c], sel); w.w = __builtin_amdgcn_perm(vv1[7][c], vv1[6][c], sel);
            o[dt] = __builtin_amdgcn_mfma_f32_32x32x16_bf16(__builtin_bit_cast(bf16x8, w), pa1, o[dt], 0, 0, 0); }
    }
    lsum += __shfl_xor(lsum, 32);
    const float inv = 1.0f / lsum;
    bf16_t* op = afm + (size_t)(w * 32 + q) * NAFM + 1536 + h * 256;
#pragma unroll
    for (int r = 0; r < 16; ++r) {
        u32x4 w; w.x = cvt_pk_bf16(o[0][r] * inv, o[1][r] * inv); w.y = cvt_pk_bf16(o[2][r] * inv, o[3][r] * inv); w.z = cvt_pk_bf16(o[4][r] * inv, o[5][r] * inv); w.w = cvt_pk_bf16(o[6][r] * inv, o[7][r] * inv);
        *(u32x4*)(op + 8 * crow(r, hi)) = w; }
}

__device__ __forceinline__ int t5_bucket(int rel) {
    const int n = rel < 0 ? -rel : rel; const float nf = (float)(n < 1 ? 1 : n);
    int large = 8 + (int)(logf(nf / 8.0f) / 4.852030263919617f * 8.0f); large = large < 15 ? large : 15;
    return (rel > 0 ? 16 : 0) + (n < 8 ? n : large);
}


#define XB_TMO      128
#define XB_XCNT(j)  (256  + 64 * (j))
#define XB_XSUB(j)  (1280 + 64 * (j))
#define XB_XGEN(j)  (2304 + 64 * (j))
#define XB_TOP      3328
#define XB_TOPGEN   3392
#define XCD_BAR_WORDS 3456
#define XB_SPIN_CAP (1u << 22)
__device__ __forceinline__ unsigned xb_ld(unsigned* p)              { return __hip_atomic_load(p, __ATOMIC_RELAXED, __HIP_MEMORY_SCOPE_AGENT); }
__device__ __forceinline__ unsigned xb_add(unsigned* p, unsigned v) { return __hip_atomic_fetch_add(p, v, __ATOMIC_RELAXED, __HIP_MEMORY_SCOPE_AGENT); }
__device__ __forceinline__ unsigned xb_xcc_id() { return (unsigned)__builtin_amdgcn_s_getreg((3 << 11) | 20) & 0xFu; }
#define XB_SPIN(cond, bar) do { unsigned _sp = 0; while (cond) { __builtin_amdgcn_s_sleep(1); \
    if ((++_sp & 255u) == 0u) { if (xb_ld(&(bar)[XB_TMO])) break; if (_sp > XB_SPIN_CAP) { atomicAdd(&(bar)[XB_TMO], 1u); break; } } } } while (0)
struct XcdBarrier { unsigned* bar; unsigned x; volatile LAS unsigned* st; };
__device__ __forceinline__ XcdBarrier xcd_barrier_post(unsigned* bar, volatile LAS unsigned* st) {
    XcdBarrier b; b.bar = bar; b.x = xb_xcc_id(); b.st = st;
    if (threadIdx.x == 0) (void)xb_add(&bar[XB_XCNT(b.x)], 1u);
    return b;
}
__device__ __forceinline__ void xcd_barrier_complete(unsigned* bar, unsigned x, unsigned& nloc, unsigned& nx) {
    const unsigned G = gridDim.x * gridDim.y * gridDim.z;
    unsigned sum, cnt, mine, sp = 0u;
    for (;;) {
        sum = 0u; cnt = 0u; mine = 0u;
#pragma unroll
        for (unsigned j = 0; j < 16; ++j) { const unsigned c = xb_ld(&bar[XB_XCNT(j)]); sum += c; cnt += (c > 0u) ? 1u : 0u; mine = (j == x) ? c : mine; }
        if (sum == G) break;
        __builtin_amdgcn_s_sleep(1);
        if ((++sp & 255u) == 0u) { if (xb_ld(&bar[XB_TMO])) break; if (sp > XB_SPIN_CAP) { atomicAdd(&bar[XB_TMO], 1u); break; } }
    }
    nloc = mine > 0u ? mine : 1u; nx = cnt > 0u ? cnt : 1u;
}
__device__ __forceinline__ void xcd_barrier(const XcdBarrier& b) {
    asm volatile("s_waitcnt vmcnt(0)" ::: "memory");
    __syncthreads();
    if (threadIdx.x == 0) {
        unsigned* bar = b.bar;
        __builtin_amdgcn_s_waitcnt(0);
        unsigned nloc = b.st[0], nx = b.st[1];
        if (nloc == 0u) { xcd_barrier_complete(bar, b.x, nloc, nx); b.st[0] = nloc; b.st[1] = nx; }
        const unsigned old = xb_add(&bar[XB_XSUB(b.x)], 1u);
        const unsigned gen = old / nloc;
        if (old + 1u == (gen + 1u) * nloc) {
            __builtin_amdgcn_fence(__ATOMIC_RELEASE, "agent");
            asm volatile("s_waitcnt vmcnt(0)" ::: "memory");
            const unsigned og = xb_add(&bar[XB_TOP], 1u);
            const unsigned tg = og / nx;
            if (og + 1u == (tg + 1u) * nx) xb_add(&bar[XB_TOPGEN], 1u);
            else XB_SPIN(xb_ld(&bar[XB_TOPGEN]) == tg, bar);
            __builtin_amdgcn_fence(__ATOMIC_ACQUIRE, "agent");
            xb_add(&bar[XB_XGEN(b.x)], 1u);
            asm volatile("s_waitcnt vmcnt(0)" ::: "memory");
        } else {
            XB_SPIN(xb_ld(&bar[XB_XGEN(b.x)]) == gen, bar);
            __builtin_amdgcn_fence(__ATOMIC_ACQUIRE, "agent");
            asm volatile("s_waitcnt vmcnt(0)" ::: "memory");
        }
    }
    __syncthreads();
}

struct Args { const float* in[24]; float* out; unsigned char* ws; int ph_lo, ph_hi, coop, pad; };
constexpr int N_PHASES = 28;

__global__ void __launch_bounds__(512, 2) mk_fwd(Args args) {
    extern __shared__ __attribute__((aligned(16))) unsigned char lds_raw[];
    LAS unsigned char* lds = (LAS unsigned char*)lds_raw;
    const int G = gridDim.x, bx = blockIdx.x;
    unsigned char* ws = args.ws;
    float* out = args.out;
    bf16_t* XN = (bf16_t*)(ws + WS_XN); bf16_t* Hb = (bf16_t*)(ws + WS_H);
    bf16_t* ZG = (bf16_t*)(ws + WS_ZG); bf16_t* GG = (bf16_t*)(ws + WS_GG); bf16_t* AFM = (bf16_t*)(ws + WS_AFM); bf16_t* YT = (bf16_t*)(ws + WS_YT); float* LSE = (float*)(ws + WS_LSE);
    bf16_t* DS2 = (bf16_t*)(ws + WS_DS2); bf16_t* DS4 = (bf16_t*)(ws + WS_DS4); bf16_t* D256 = (bf16_t*)(ws + WS_D256);
    bf16_t* MEMN = (bf16_t*)(ws + WS_MEMN); bf16_t* KV = (bf16_t*)(ws + WS_KV); bf16_t* YF = (bf16_t*)(ws + WS_YF);
#if MK_COOP
    cg::grid_group grid = cg::this_grid();
    volatile LAS unsigned* xst = (volatile LAS unsigned*)(lds + 139264 + 64);
    if (threadIdx.x < 2) xst[threadIdx.x] = 0u;
    __syncthreads();
    const XcdBarrier xbar = xcd_barrier_post((unsigned*)ws, xst);
#endif

#ifndef PROBE_MASK
#define PROBE_MASK 0u
#endif
    for (int pi = args.ph_lo; pi < args.ph_hi; ++pi) {
        int ph = 0; { int acc_ = 0; for (int p_ = 0; p_ < N_PHASES; ++p_) { const int w_ = 1 + (int)((PROBE_MASK >> p_) & 1u); if (pi >= acc_ && pi < acc_ + w_) ph = p_; acc_ += w_; } }
        int tid = threadIdx.x; asm volatile("" : "+v"(tid));
        const int lane = tid & 63, wave = __builtin_amdgcn_readfirstlane(tid >> 6);
        const int gw = bx * 8 + wave, ngw = G * 8;
        const bool mix = (ph >= 4 && ph < 25);
        const int chunk = mix ? (ph - 4) / 7 : 0, mk = mix ? (ph - 4) % 7 : -1;
        const int S = (chunk == 2) ? 4096 : 2048, nseq = (chunk == 2) ? 4 : 8;
        const size_t crow0 = (size_t)chunk * CH;

        if (ph == 0) {
            LAS float* scr = (LAS float*)(lds + wave * 17408);
            convert_weight(args.in[6], DM, 2 * DFF, (bf16_t*)(ws + WS_W1U), DM, 0, true, scr, gw, ngw, lane);
            convert_weight(args.in[7], DFF, DM, (bf16_t*)(ws + WS_W1D), DFF, 0, false, scr, gw, ngw, lane);
            convert_weight(args.in[11], DM, NIN, (bf16_t*)(ws + WS_WIN), DM, 0, false, scr, gw, ngw, lane);
            convert_weight(args.in[13], DM, NGT, (bf16_t*)(ws + WS_WG), DM, 0, false, scr, gw, ngw, lane);
            convert_weight(args.in[12], DM, DM, (bf16_t*)(ws + WS_WKV), DM, 0, false, scr, gw, ngw, lane);
            convert_weight(args.in[15], 512, DM, (bf16_t*)(ws + WS_WP), NAFM, 0, false, scr, gw, ngw, lane);
            convert_weight(args.in[16], 1024, DM, (bf16_t*)(ws + WS_WP), NAFM, 512, false, scr, gw, ngw, lane);
            convert_weight(args.in[17], 1024, DM, (bf16_t*)(ws + WS_WP), NAFM, 1536, false, scr, gw, ngw, lane);
            convert_weight(args.in[18], DM, DM, (bf16_t*)(ws + WS_WO), DM, 0, false, scr, gw, ngw, lane);
            for (int row = gw; row < TT; row += ngw) {
                const float* xr = (row < TP) ? args.in[0] + (size_t)row * DM : args.in[1] + (size_t)(row - TP) * DM;
                row_op<false, false>(nullptr, xr, nullptr, XN + (size_t)row * DM, nullptr, args.in[5], 0.f, lane);
            }
        }
#ifndef DIS_G1
        if (ph == 1 || ph == 25) {
            SchedStd Sd; Sd.so.init(TT, 2 * DFF, G, bx); Sd.A = (const char*)XN; Sd.B = (const char*)(ws + WS_W1U); Sd.C = Hb;
            Sd.a_tile = (size_t)256 * DM * 2; Sd.b_tile = (size_t)256 * DM * 2; Sd.ldc = DFF; Sd.ccols = 128; Sd.nt = DM / 64;
            pg8::EpiSwiGLU E{DFF};
            pg8::gemm_phase<pg8::EpiSwiGLU, SchedStd>(lds, tid, DM, DM, Sd, E);
        }
#endif
#ifndef DIS_G2
        if (ph == 2 || ph == 26 || mk == 0 || mk == 5) {
            const int nrep = (mk == 0) ? (bx >= 128 ? 3 : 2) : 1;
            for (int rep = 0; rep < nrep; ++rep) {
                SchedStd Sd; int lda, ldb;
                if (ph == 2 || ph == 26) { Sd.so.init(TT, DM, G, bx); Sd.A = (const char*)Hb; Sd.B = (const char*)(ws + WS_W1D); Sd.C = XN; lda = DFF; ldb = DFF; Sd.ldc = DM; Sd.nt = DFF / 64; }
                else if (mk == 0 && rep == 0) { Sd.so.init(CH, NIN, G, bx); Sd.A = (const char*)(XN + crow0 * DM); Sd.B = (const char*)(ws + WS_WIN); Sd.C = ZG; lda = DM; ldb = DM; Sd.ldc = NIN; Sd.nt = DM / 64; }
                else if (mk == 0 && rep == 1) { Sd.so.init(CH, NGT, G, bx); Sd.A = (const char*)(XN + crow0 * DM); Sd.B = (const char*)(ws + WS_WG); Sd.C = GG; lda = DM; ldb = DM; Sd.ldc = NGT; Sd.nt = DM / 64; }
                else if (mk == 0) { const int mrow0 = (chunk == 2 ? 16 : chunk * 8) * 256; Sd.so.init(nseq * 256, DM, G - 128, bx - 128); Sd.A = (const char*)(MEMN + (size_t)mrow0 * DM); Sd.B = (const char*)(ws + WS_WKV); Sd.C = KV + (size_t)mrow0 * DM; lda = DM; ldb = DM; Sd.ldc = DM; Sd.nt = DM / 64; }
                else { Sd.so.init(CH, DM, G, bx); Sd.A = (const char*)YT; Sd.B = (const char*)(ws + WS_WO); Sd.C = ZG; lda = DM; ldb = DM; Sd.ldc = DM; Sd.nt = DM / 64; }
                Sd.a_tile = (size_t)256 * lda * 2; Sd.b_tile = (size_t)256 * ldb * 2; Sd.ccols = 256;
                pg8::EpiStore<0> E{Sd.ldc, nullptr};
                pg8::gemm_phase<pg8::EpiStore<0>, SchedStd>(lds, tid, lda, ldb, Sd, E);
            }
        }
#endif
#ifndef DIS_R3
        if (ph == 3) {
            for (int row = gw; row < TT; row += ngw) {
                const float* xr = (row < TP) ? args.in[0] + (size_t)row * DM : args.in[1] + (size_t)(row - TP) * DM;
                row_op<false, true>(XN + (size_t)row * DM, xr, out + (size_t)row * DM, XN + (size_t)row * DM, args.in[8], args.in[9], 0.5f, lane);
            }
            for (int row = gw; row < 5120; row += ngw) {
                const float* xr = (row < 4096) ? args.in[2] + (size_t)row * DM : args.in[3] + (size_t)(row - 4096) * DM;
                row_op<false, false>(nullptr, xr, nullptr, MEMN + (size_t)row * DM, nullptr, args.in[10], 0.f, lane);
            }
            { LAS float* scr = (LAS float*)(lds + wave * 17408);
              convert_weight(args.in[21], DM, 2 * DFF, (bf16_t*)(ws + WS_W1U), DM, 0, true, scr, gw, ngw, lane);
              convert_weight(args.in[22], DFF, DM, (bf16_t*)(ws + WS_W1D), DFF, 0, false, scr, gw, ngw, lane); }
            const int gt = bx * 512 + tid, ngt = G * 512;
            LAS float* ctab = (LAS float*)lds;
            for (int which = 0; which < 2; ++which) {
                const int SS = which ? 4096 : 2048; bf16_t* DS = which ? DS4 : DS2; const float scl = which ? 0.015625f : 0.022097086912079608f; const float inv = 2.0f / (float)SS;
                __syncthreads();
                for (int m_ = tid; m_ < SS; m_ += 512) ctab[m_] = cospif((float)m_ * inv) * scl;
                __syncthreads();
                const int per_row = SS / 8, total = SS * per_row, hS = SS >> 1;
                for (int idx = gt; idx < total; idx += ngt) { const int j = idx / per_row, k8 = (idx - j * per_row) * 8; float vv[8];
#pragma unroll
                    for (int e = 0; e < 8; ++e) { const int k = k8 + e; const int mm = (k <= hS) ? ((j * k) & (SS - 1)) : ((j * (k - hS) + (SS >> 2)) & (SS - 1)); vv[e] = ctab[mm]; }
                    u32x4 w; w.x = cvt_pk_bf16(vv[0], vv[1]); w.y = cvt_pk_bf16(vv[2], vv[3]); w.z = cvt_pk_bf16(vv[4], vv[5]); w.w = cvt_pk_bf16(vv[6], vv[7]);
                    *(u32x4*)(DS + (size_t)j * SS + k8) = w; }
            }
            __syncthreads();
            for (int idx = gt; idx < 512 * 256 / 8; idx += ngt) { const int mrow = idx / 32, c8 = (idx - mrow * 32) * 8; float vv[8];
#pragma unroll
                for (int e = 0; e < 8; ++e) { const int cc = c8 + e; const int mm = ((mrow & 255) * cc) & 255; const float x = (float)mm * (2.0f / 256.0f);
                    vv[e] = (mrow >= 256) ? sinpif(x) * 0.0625f : cospif(x) * 0.0625f; }
                u32x4 w; w.x = cvt_pk_bf16(vv[0], vv[1]); w.y = cvt_pk_bf16(vv[2], vv[3]); w.z = cvt_pk_bf16(vv[4], vv[5]); w.w = cvt_pk_bf16(vv[6], vv[7]);
                *(u32x4*)(D256 + (size_t)mrow * 256 + c8) = w; }
        }
#endif
#ifndef DIS_M1
        if (mk == 1) {
#ifndef DIS_F1
            { SchedF1 Sf{(const char*)D256, (const char*)ZG, YT, S, nseq * 4 * 2 * (S >> 8), G, bx};
              pg8::EpiStore<0> E{2 * S, nullptr};
              pg8::gemm_phase<pg8::EpiStore<0>, SchedF1>(lds, tid, 256, NIN, Sf, E); }
#endif
            LAS float* biasL = (LAS float*)lds;
#ifndef DIS_BIAS
            for (int idx = tid; idx < 12 * 129; idx += 512) { const int h12 = idx / 129, dd = idx - h12 * 129 - 64; const int g = h12 >> 2;
                biasL[h12 * 132 + dd + 64] = args.in[4][t5_bucket(dd * (1 << (2 * g))) * 12 + h12] * LOG2E; }
#endif
            __syncthreads();
#ifndef DIS_DIL
            for (int u = gw; u < 12 * 512; u += ngw) dil_attn_unit(ZG, LSE, biasL, S, u, lane);
#endif
#ifndef DIS_MEM
            for (int u = gw; u < 4 * 512; u += ngw) { const int w = u & 511; const int bglob = (chunk == 2 ? 16 : chunk * 8) + (w * 32) / S;
                mem_attn_unit(ZG, KV + (size_t)bglob * 256 * 2048, AFM, u, lane); }
#endif
            __syncthreads();
        }
#endif
#ifndef DIS_M2
        if (mk == 2) {
            {
                const int hS = S >> 1, per_row = S / 8, total = nseq * 1024 * per_row; const int gt = bx * 512 + tid, ngt = G * 512;
                for (int idx = gt; idx < total; idx += ngt) { const int row = idx / per_row, k8 = (idx - row * per_row) * 8; const bf16_t* yr = YT + (size_t)row * (2 * S); float vv[8];
                    const bool sinp = (k8 >= hS); const int s8 = sinp ? k8 - hS : k8;
                    const bf16_t* fp = yr + (sinp ? S : 0) + s8;
                    const bf16_t* mp = yr + (sinp ? 2 * S : S) - s8 - 8;
                    const u32x4 fw = *(const u32x4*)fp, mw = *(const u32x4*)mp; const float m0 = bf_lo((unsigned)mp[8]);
                    const float f[8] = {bf_lo(fw.x), bf_hi(fw.x), bf_lo(fw.y), bf_hi(fw.y), bf_lo(fw.z), bf_hi(fw.z), bf_lo(fw.w), bf_hi(fw.w)};
                    const float mr[8] = {m0, bf_hi(mw.w), bf_lo(mw.w), bf_hi(mw.z), bf_lo(mw.z), bf_hi(mw.y), bf_lo(mw.y), bf_hi(mw.x)};
#pragma unroll
                    for (int e = 0; e < 8; ++e) vv[e] = sinp ? f[e] - mr[e] : f[e] + mr[e];
                    if (s8 == 0) vv[0] = sinp ? bf_lo((unsigned)yr[hS]) : f[0];
                    u32x4 w; w.x = cvt_pk_bf16(vv[0], vv[1]); w.y = cvt_pk_bf16(vv[2], vv[3]); w.z = cvt_pk_bf16(vv[4], vv[5]); w.w = cvt_pk_bf16(vv[6], vv[7]);
                    *(u32x4*)(YF + (size_t)row * S + k8) = w; }
            }
            for (int t = gw; t < CH; t += ngw) { const int j = lane >> 4, e0 = (lane & 15) * 8;
                const float l0 = LSE[(size_t)t * 12 + j], l1 = LSE[(size_t)t * 12 + 4 + j], l2 = LSE[(size_t)t * 12 + 8 + j];
                const float mxl = fmaxf(l0, fmaxf(l1, l2)); float w0 = __builtin_amdgcn_exp2f(l0 - mxl), w1 = __builtin_amdgcn_exp2f(l1 - mxl), w2 = __builtin_amdgcn_exp2f(l2 - mxl);
                const float iw = 1.0f / (w0 + w1 + w2); w0 *= iw; w1 *= iw; w2 *= iw;
                const bf16_t* zr = ZG + (size_t)t * NIN + j * 128 + e0;
                const u32x4 a = *(const u32x4*)zr, b = *(const u32x4*)(zr + 512), c = *(const u32x4*)(zr + 1024);
                u32x4 o;
                o.x = cvt_pk_bf16(w0 * bf_lo(a.x) + w1 * bf_lo(b.x) + w2 * bf_lo(c.x), w0 * bf_hi(a.x) + w1 * bf_hi(b.x) + w2 * bf_hi(c.x));
                o.y = cvt_pk_bf16(w0 * bf_lo(a.y) + w1 * bf_lo(b.y) + w2 * bf_lo(c.y), w0 * bf_hi(a.y) + w1 * bf_hi(b.y) + w2 * bf_hi(c.y));
                o.z = cvt_pk_bf16(w0 * bf_lo(a.z) + w1 * bf_lo(b.z) + w2 * bf_lo(c.z), w0 * bf_hi(a.z) + w1 * bf_hi(b.z) + w2 * bf_hi(c.z));
                o.w = cvt_pk_bf16(w0 * bf_lo(a.w) + w1 * bf_lo(b.w) + w2 * bf_lo(c.w), w0 * bf_hi(a.w) + w1 * bf_hi(b.w) + w2 * bf_hi(c.w));
                *(u32x4*)(AFM + (size_t)t * NAFM + j * 128 + e0) = o; }
        }
#endif
        if (mk == 3) {
            SchedF2 Sf{(const char*)(chunk == 2 ? DS4 : DS2), (const char*)YF, AFM, S, nseq * (S >> 8) * 4, G, bx};
            pg8::EpiStore<0> E{NAFM, nullptr};
            pg8::gemm_phase<pg8::EpiStore<0>, SchedF2>(lds, tid, S, S, Sf, E);
        }
#ifndef DIS_M4
        if (mk == 4) {
            SchedP Sp; Sp.so.init(CH, DM, G, bx); Sp.AFM = (const char*)AFM; Sp.WP = (const char*)(ws + WS_WP); Sp.Gc = GG; Sp.Mg = YT;
            pg8::EpiGateRMW E{DM, args.in[14], NGT};
            pg8::gemm_phase<pg8::EpiGateRMW, SchedP>(lds, tid, NAFM, NAFM, Sp, E);
        }
#endif
#ifndef DIS_R6
        if (mk == 6 || ph == 27) {
            const int r0 = (ph == 27) ? 0 : (int)crow0, nr = (ph == 27) ? TT : CH;
            for (int row = gw; row < nr; row += ngw) { const size_t gr = (size_t)(r0 + row);
                const bf16_t* yr = (ph == 27) ? XN + gr * DM : ZG + (size_t)row * DM;
                if (ph == 27) row_op<true, false>(yr, out + gr * DM, out + gr * DM, nullptr, args.in[23], args.in[20], 0.5f, lane);
                else row_op<true, true>(yr, out + gr * DM, out + gr * DM, XN + gr * DM, args.in[19], args.in[20], 1.0f, lane); }
        }
#endif

#if MK_COOP
        if (pi + 1 < args.ph_hi) { if (pi == args.ph_lo) grid.sync(); else xcd_barrier(xbar); }
#endif
    }
}

extern "C" void kernel_launch(void* const* d_in, const int* in_sizes, int n_in, void* d_out, int out_size, void* d_ws, size_t ws_size, hipStream_t stream) {
    static int grid = 0;
    if (grid == 0) {
        if (n_in != 24 || out_size != TT * DM || ws_size < WS_END) { fprintf(stderr, "kernel_launch: unexpected shapes (n_in %d out %d ws %zu)\n", n_in, out_size, ws_size); grid = -1; return; }
        int dev = 0, cus = 0, per_cu = 0;
        hipGetDevice(&dev); hipDeviceGetAttribute(&cus, hipDeviceAttributeMultiprocessorCount, dev);
        if (hipFuncSetAttribute((const void*)mk_fwd, hipFuncAttributeMaxDynamicSharedMemorySize, LDS_BYTES) != hipSuccess) { fprintf(stderr, "kernel_launch: hipFuncSetAttribute failed\n"); grid = -1; return; }
        if (hipOccupancyMaxActiveBlocksPerMultiprocessor(&per_cu, (const void*)mk_fwd, 512, LDS_BYTES) != hipSuccess || per_cu < 1) { fprintf(stderr, "kernel_launch: occupancy query says %d\n", per_cu); per_cu = 1; }
        (void)hipGetLastError();
        grid = cus * 1;
    }
    if (grid < 0) return;
    Args a{};
    for (int i = 0; i < 24; ++i) a.in[i] = (const float*)d_in[i];
    a.out = (float*)d_out; a.ws = (unsigned char*)d_ws;
#if MK_COOP
    (void)hipMemsetAsync(d_ws, 0, 16384, stream);
    a.ph_lo = 0; a.ph_hi = N_PHASES + __builtin_popcount(PROBE_MASK); a.coop = 1;
    void* kargs[] = {&a};
    hipError_t e = hipLaunchCooperativeKernel((const void*)mk_fwd, dim3(grid), dim3(512), kargs, LDS_BYTES, stream);
    if (e != hipSuccess) fprintf(stderr, "cooperative launch failed: %s (grid %d)\n", hipGetErrorString(e), grid);
#else
    for (int ph = 0; ph < N_PHASES; ++ph) {
        a.ph_lo = ph; a.ph_hi = ph + 1; a.coop = 0;
        hipLaunchKernelGGL(mk_fwd, dim3(grid), dim3(512), LDS_BYTES, stream, a);
    }
#endif
}
```
